# Optimizing an MI355X kernel written in HIP

```python
import jax, jax.numpy as jnp
from jax import lax
import numpy as np

D_MODEL = 1024
BATCH = 4
SEQ = 4096
DEPTH = 2

GRID_W = 64
CTX_LEN = 256
N_Q_HEADS = 8
N_KV_HEADS = 2
HEAD_DIM = 64
ATTN_WIDTH = N_Q_HEADS * HEAD_DIM
KV_WIDTH = N_KV_HEADS * HEAD_DIM
Q_BLOCK = 128
ROPE_THETA = 10000.0
POOL_WINDOWS = (2, 4, 8, 16)
N_POOL_GROUPS = 4
POOL_GROUP_DIM = 128
POOL_WIDTH = N_POOL_GROUPS * POOL_GROUP_DIM
MIX_IN_WIDTH = ATTN_WIDTH + 2 * KV_WIDTH + POOL_WIDTH
MIX_OUT_WIDTH = ATTN_WIDTH + POOL_WIDTH
CONV_WIDTH = D_MODEL
CONV_K = 3
N_EXPERTS = 16
EXPERT_FF = 1024
CAPACITY_FACTOR = 2
NORM_EPS = 1e-6
DEEPNORM_ALPHA = (2 * DEPTH) ** 0.25
DEEPNORM_BETA = (8 * DEPTH) ** -0.25

kernel_name = 'hybrid_flow_trunk_gqa_pool_shortconv_ecmoe'


def _layer_norm(x, g, b):
    xf = x.astype(jnp.float32)
    mu = jnp.mean(xf, axis=-1, keepdims=True)
    xc = xf - mu
    var = jnp.mean(xc * xc, axis=-1, keepdims=True)
    y = xc * lax.rsqrt(var + NORM_EPS) * g.astype(jnp.float32) + b.astype(jnp.float32)
    return y.astype(x.dtype)


def _rms_norm(x, g):
    xf = x.astype(jnp.float32)
    y = xf * lax.rsqrt(jnp.mean(xf * xf, axis=-1, keepdims=True) + NORM_EPS)
    return (y * g.astype(jnp.float32)).astype(x.dtype)


def _modulation(cond, w, b):
    m = (cond @ w + b)[:, None, :]
    return jnp.split(m, 6, axis=-1)


def _modulate(h, shift, scale):
    return h * (1.0 + scale) + shift


def _post_norm(h, branch, g, b):
    return _layer_norm(DEEPNORM_ALPHA * h + branch, g, b)


def _axial_rope_tables(rows):
    row = jnp.broadcast_to(jnp.arange(rows, dtype=jnp.float32)[:, None], (rows, GRID_W)).reshape(-1)
    col = jnp.broadcast_to(jnp.arange(GRID_W, dtype=jnp.float32)[None, :], (rows, GRID_W)).reshape(-1)
    axis_dim = HEAD_DIM // 2
    inv_freq = ROPE_THETA ** (-jnp.arange(0, axis_dim, 2, dtype=jnp.float32) / axis_dim)
    ang = jnp.concatenate([row[:, None] * inv_freq, col[:, None] * inv_freq], axis=-1)
    return jnp.cos(ang), jnp.sin(ang)


def _apply_rope(x, cos, sin):
    xf = x.astype(jnp.float32).reshape(x.shape[:-1] + (HEAD_DIM // 2, 2))
    x0, x1 = xf[..., 0], xf[..., 1]
    c = cos[None, :, None, :]
    s = sin[None, :, None, :]
    out = jnp.stack([x0 * c - x1 * s, x0 * s + x1 * c], axis=-1).reshape(x.shape)
    return out.astype(x.dtype)


def _blocked_attention(q, k, v):
    b, lq = q.shape[:2]
    grp = N_Q_HEADS // N_KV_HEADS
    nb = lq // Q_BLOCK
    qb = q.reshape(b, nb, Q_BLOCK, N_KV_HEADS, grp, HEAD_DIM).transpose(1, 0, 2, 3, 4, 5)
    scale = HEAD_DIM ** -0.5

    def one_block(qi):
        s = jnp.einsum('bqhgd,bkhd->bhgqk', qi, k, preferred_element_type=jnp.float32) * scale
        p = jax.nn.softmax(s, axis=-1)
        return jnp.einsum('bhgqk,bkhd->bqhgd', p.astype(v.dtype), v)

    o = lax.map(one_block, qb)
    return o.transpose(1, 0, 2, 3, 4, 5).reshape(b, lq, ATTN_WIDTH)


def _pool_branch(p, w_grp, p_scale):
    b, l, _ = p.shape
    pf = p.astype(jnp.float32)
    cs = jnp.concatenate([jnp.zeros((b, 1, POOL_WIDTH), jnp.float32), jnp.cumsum(pf, axis=1)], axis=1)
    t = jnp.arange(l)
    means = []
    for g, w in enumerate(POOL_WINDOWS):
        lo = jnp.maximum(t - w // 2, 0)
        hi = jnp.minimum(t + w // 2, l)
        seg = cs[:, :, g * POOL_GROUP_DIM:(g + 1) * POOL_GROUP_DIM]
        cnt = (hi - lo).astype(jnp.float32)[None, :, None]
        means.append((seg[:, hi] - seg[:, lo]) / cnt)
    pooled = (jnp.concatenate(means, axis=-1) - pf).astype(p.dtype)
    pooled = pooled.reshape(b, l, N_POOL_GROUPS, POOL_GROUP_DIM)
    out = jnp.einsum('blgc,gcd->blgd', pooled, w_grp).reshape(b, l, POOL_WIDTH)
    return out * p_scale


def _split_mix_in(h):
    return jnp.split(h, [ATTN_WIDTH, ATTN_WIDTH + KV_WIDTH, ATTN_WIDTH + 2 * KV_WIDTH], axis=-1)


def _attn_pool_mixer(u_lat, u_ctx, cos, sin, w_in, q_g, k_g, w_grp, p_scale, w_out, ctx_out):
    b, s, _ = u_lat.shape
    lc = u_ctx.shape[1]
    q, k, v, p = _split_mix_in(u_lat @ w_in)
    q = _apply_rope(_rms_norm(q.reshape(b, s, N_Q_HEADS, HEAD_DIM), q_g), cos, sin)
    k = _apply_rope(_rms_norm(k.reshape(b, s, N_KV_HEADS, HEAD_DIM), k_g), cos, sin)
    v = v.reshape(b, s, N_KV_HEADS, HEAD_DIM)
    if ctx_out:
        qc, kc, vc, pc = _split_mix_in(u_ctx @ w_in)
    else:
        kc, vc = jnp.split(u_ctx @ w_in[:, ATTN_WIDTH:ATTN_WIDTH + 2 * KV_WIDTH], 2, axis=-1)
    kc = _rms_norm(kc.reshape(b, lc, N_KV_HEADS, HEAD_DIM), k_g)
    vc = vc.reshape(b, lc, N_KV_HEADS, HEAD_DIM)
    k_all = jnp.concatenate([kc, k], axis=1)
    v_all = jnp.concatenate([vc, v], axis=1)
    a_lat = _blocked_attention(q, k_all, v_all)
    y_lat = jnp.concatenate([a_lat, _pool_branch(p, w_grp, p_scale)], axis=-1) @ w_out
    y_ctx = None
    if ctx_out:
        qc = _rms_norm(qc.reshape(b, lc, N_Q_HEADS, HEAD_DIM), q_g)
        a_ctx = _blocked_attention(qc, kc, vc)
        y_ctx = jnp.concatenate([a_ctx, _pool_branch(pc, w_grp, p_scale)], axis=-1) @ w_out
    return y_lat, y_ctx


def _short_conv_mixer(u, w_in, conv_w, w_out):
    b_gate, c_gate, x_in = jnp.split(u @ w_in, 3, axis=-1)
    z = lax.conv_general_dilated(c_gate * x_in, conv_w[:, None, :], window_strides=(1,),
                                 padding=((CONV_K // 2, CONV_K // 2),),
                                 dimension_numbers=('NWC', 'WIO', 'NWC'),
                                 feature_group_count=CONV_WIDTH)
    return (b_gate * z) @ w_out


def _expert_choice_ffn(u, w_router, w_g, w_u, w_d):
    b, n, _ = u.shape
    cap = CAPACITY_FACTOR * n // N_EXPERTS
    logits = jnp.einsum('bnd,de->ben', u, w_router, preferred_element_type=jnp.float32)
    aff = jax.nn.softmax(logits, axis=1)
    gate, idx = lax.top_k(aff, cap)
    bidx = jnp.arange(b)[:, None, None]
    xe = u[bidx, idx]
    hg = jnp.einsum('becd,edf->becf', xe, w_g)
    hu = jnp.einsum('becd,edf->becf', xe, w_u)
    ye = jnp.einsum('becf,efd->becd', jax.nn.silu(hg) * hu, w_d) * gate[..., None].astype(u.dtype)
    return jnp.zeros_like(u).at[bidx, idx].add(ye)


def setup_inputs(seed: int = 0) -> dict:
    key = jax.random.key(seed)
    ks = jax.random.split(key, 24)
    f32 = jnp.float32
    n_even = (DEPTH + 1) // 2
    n_odd = DEPTH // 2

    def dense(k, shape, fan_in, mult=1.0):
        return jax.random.normal(k, shape, f32) * (mult * fan_in ** -0.5)

    def gain(k, shape):
        return 1.0 + 0.02 * jax.random.normal(k, shape, f32)

    def small(k, shape):
        return 0.02 * jax.random.normal(k, shape, f32)

    return {
        'x': jax.random.normal(ks[0], (BATCH, SEQ, D_MODEL), f32),
        'c': jax.random.normal(ks[1], (BATCH, D_MODEL), f32),
        'ctx': jax.random.normal(ks[2], (BATCH, CTX_LEN, D_MODEL), f32),
        'c_ctx': jax.random.normal(ks[3], (D_MODEL,), f32),
        'w_mod': dense(ks[4], (DEPTH, D_MODEL, 6 * D_MODEL), D_MODEL, 0.5),
        'b_mod': 0.01 * jax.random.normal(ks[5], (DEPTH, 6 * D_MODEL), f32),
        'ln_mix_g': gain(ks[6], (DEPTH, D_MODEL)),
        'ln_mix_b': small(ks[7], (DEPTH, D_MODEL)),
        'ln_ffn_g': gain(ks[8], (DEPTH, D_MODEL)),
        'ln_ffn_b': small(ks[9], (DEPTH, D_MODEL)),
        'w_mix_in': dense(ks[10], (n_even, D_MODEL, MIX_IN_WIDTH), D_MODEL),
        'q_norm_g': gain(ks[11], (n_even, HEAD_DIM)),
        'k_norm_g': gain(ks[12], (n_even, HEAD_DIM)),
        'w_pool_grp': dense(ks[13], (n_even, N_POOL_GROUPS, POOL_GROUP_DIM, POOL_GROUP_DIM), POOL_GROUP_DIM),
        'pool_scale': gain(ks[14], (n_even, POOL_WIDTH)),
        'w_mix_out': dense(ks[15], (n_even, MIX_OUT_WIDTH, D_MODEL), MIX_OUT_WIDTH, DEEPNORM_BETA),
        'w_conv_in': dense(ks[16], (n_odd, D_MODEL, 3 * CONV_WIDTH), D_MODEL),
        'conv_w': dense(ks[17], (n_odd, CONV_K, CONV_WIDTH), CONV_K),
        'w_conv_out': dense(ks[18], (n_odd, CONV_WIDTH, D_MODEL), CONV_WIDTH, DEEPNORM_BETA),
        'w_router': dense(ks[19], (DEPTH, D_MODEL, N_EXPERTS), D_MODEL),
        'w_exp_gate': dense(ks[20], (DEPTH, N_EXPERTS, D_MODEL, EXPERT_FF), D_MODEL),
        'w_exp_up': dense(ks[21], (DEPTH, N_EXPERTS, D_MODEL, EXPERT_FF), D_MODEL),
        'w_exp_down': dense(ks[22], (DEPTH, N_EXPERTS, EXPERT_FF, D_MODEL), EXPERT_FF, DEEPNORM_BETA),
    }


def reference(x, c, ctx, c_ctx, w_mod, b_mod, ln_mix_g, ln_mix_b, ln_ffn_g, ln_ffn_b,
              w_mix_in, q_norm_g, k_norm_g, w_pool_grp, pool_scale, w_mix_out,
              w_conv_in, conv_w, w_conv_out,
              w_router, w_exp_gate, w_exp_up, w_exp_down):
    rows = x.shape[1] // GRID_W
    cos, sin = _axial_rope_tables(rows)
    cond_lat = jax.nn.silu(c)
    cond_ctx = jax.nn.silu(c_ctx)[None, :]
    h_lat, h_ctx = x, ctx
    for layer in range(DEPTH):
        is_even = layer % 2 == 0
        ctx_out = any(j % 2 == 0 for j in range(layer + 1, DEPTH))
        ctx_in = is_even or ctx_out
        m_lat = _modulation(cond_lat, w_mod[layer], b_mod[layer])
        u_lat = _modulate(h_lat, m_lat[0], m_lat[1])
        u_ctx = None
        if ctx_in:
            m_ctx = _modulation(cond_ctx, w_mod[layer], b_mod[layer])
            u_ctx = _modulate(h_ctx, m_ctx[0], m_ctx[1])
        if is_even:
            e = layer // 2
            y_lat, y_ctx = _attn_pool_mixer(u_lat, u_ctx, cos, sin, w_mix_in[e], q_norm_g[e], k_norm_g[e],
                                            w_pool_grp[e], pool_scale[e], w_mix_out[e], ctx_out)
        else:
            o = layer // 2
            y_lat = _short_conv_mixer(u_lat, w_conv_in[o], conv_w[o], w_conv_out[o])
            y_ctx = _short_conv_mixer(u_ctx, w_conv_in[o], conv_w[o], w_conv_out[o]) if ctx_out else None
        h_lat = _post_norm(h_lat, m_lat[2] * y_lat, ln_mix_g[layer], ln_mix_b[layer])
        f_lat = _expert_choice_ffn(_modulate(h_lat, m_lat[3], m_lat[4]), w_router[layer],
                                   w_exp_gate[layer], w_exp_up[layer], w_exp_down[layer])
        h_lat = _post_norm(h_lat, m_lat[5] * f_lat, ln_ffn_g[layer], ln_ffn_b[layer])
        if ctx_out:
            h_ctx = _post_norm(h_ctx, m_ctx[2] * y_ctx, ln_mix_g[layer], ln_mix_b[layer])
            f_ctx = _expert_choice_ffn(_modulate(h_ctx, m_ctx[3], m_ctx[4]), w_router[layer],
                                       w_exp_gate[layer], w_exp_up[layer], w_exp_down[layer])
            h_ctx = _post_norm(h_ctx, m_ctx[5] * f_ctx, ln_ffn_g[layer], ln_ffn_b[layer])
    return h_lat
```

```cpp
#include <hip/hip_runtime.h>
#include <hip/hip_cooperative_groups.h>
#include <cstdio>
namespace cg = cooperative_groups;

typedef unsigned short bf16_t;
using bf16x8 = __attribute__((ext_vector_type(8))) short;
using f32x16 = __attribute__((ext_vector_type(16))) float;
typedef unsigned u32x4 __attribute__((ext_vector_type(4)));
typedef unsigned u32x2 __attribute__((ext_vector_type(2)));
typedef float f32x4 __attribute__((ext_vector_type(4)));
#define DI __device__ __forceinline__
#define MFMA32(a, b, c) __builtin_amdgcn_mfma_f32_32x32x16_bf16((a), (b), (c), 0, 0, 0)

constexpr int D = 1024, NB_ = 4, S = 4096, NTOK = NB_ * S, CTXL = 256, NCTX = NB_ * CTXL;
constexpr int NKEY = S + CTXL;
constexpr int NE = 16, CAP = 512, FF = 1024;
constexpr float LN_EPS = 1e-6f;
constexpr float QSCALE = 0.125f * 1.4426950408889634f;
constexpr float ALPHA = 1.41421356237309515f;

constexpr size_t MiB = 1ull << 20;
constexpr size_t OFF_WT_IN = 0;
constexpr size_t OFF_WT_OUT = OFF_WT_IN + 1280ull * 1024 * 2;
constexpr size_t OFF_WT_POOL = OFF_WT_OUT + 2 * MiB;
constexpr size_t OFF_WT_CIN = OFF_WT_POOL + 4ull * 128 * 128 * 2;
constexpr size_t OFF_WT_COUT = OFF_WT_CIN + 6 * MiB;
constexpr size_t OFF_WT_G = OFF_WT_COUT + 2 * MiB;
constexpr size_t OFF_WT_U = OFF_WT_G + 64 * MiB;
constexpr size_t OFF_WT_D = OFF_WT_U + 64 * MiB;
constexpr size_t OFF_MOD = OFF_WT_D + 64 * MiB;
constexpr size_t OFF_ROPE = OFF_MOD + 2ull * 5 * 6144 * 4;
constexpr size_t OFF_UCTX = OFF_ROPE + 8192;
constexpr size_t OFF_M = OFF_UCTX + 2 * MiB;
constexpr size_t OFF_Q = OFF_M;
constexpr size_t OFF_K = OFF_M + 16 * MiB;
constexpr size_t OFF_VT = OFF_M + 21 * MiB;
constexpr size_t OFF_P = OFF_M + 26 * MiB;
constexpr size_t OFF_POOLED = OFF_M + 42 * MiB;
constexpr size_t OFF_CAT = OFF_M + 58 * MiB;
constexpr size_t OFF_BG = OFF_M;
constexpr size_t OFF_CX = OFF_M + 32 * MiB;
constexpr size_t OFF_Z = OFF_M + 64 * MiB;
constexpr size_t OFF_ACT = OFF_M;
constexpr size_t OFF_UB = OFF_M + 96 * MiB;
constexpr size_t OFF_Y = OFF_M + 128 * MiB;
constexpr size_t OFF_UA = OFF_Y + 32 * MiB;
constexpr size_t OFF_Y2 = OFF_Y;
constexpr size_t OFF_H1 = OFF_UA + 32 * MiB;
constexpr size_t OFF_AFF = OFF_H1 + 64 * MiB;
constexpr size_t OFF_IDX = OFF_AFF + 1 * MiB;
constexpr size_t OFF_GATEV = OFF_IDX + 128 * 1024;
constexpr size_t OFF_INV = OFF_GATEV + 128 * 1024;
constexpr size_t OFF_BAR = OFF_INV + 1 * MiB;
constexpr size_t WS_END = OFF_BAR + 16384;

struct Params {
  const float *x, *c, *ctx, *c_ctx, *w_mod, *b_mod, *ln_mix_g, *ln_mix_b, *ln_ffn_g, *ln_ffn_b;
  const float *w_mix_in, *q_norm_g, *k_norm_g, *w_pool_grp, *pool_scale, *w_mix_out;
  const float *w_conv_in, *conv_w, *w_conv_out, *w_router, *w_exp_gate, *w_exp_up, *w_exp_down;
  float* out;
  unsigned char* ws;
  int ph_lo, ph_hi;
};

DI unsigned pack2(float a, float b) {
  typedef float f2 __attribute__((ext_vector_type(2)));
  typedef __bf16 b2 __attribute__((ext_vector_type(2)));
  f2 v = {a, b};
  b2 r = __builtin_convertvector(v, b2);
  return __builtin_bit_cast(unsigned, r);
}
DI float bflo(unsigned u) { return __uint_as_float(u << 16); }
DI float bfhi(unsigned u) { return __uint_as_float(u & 0xffff0000u); }
DI uint4 pack8(const float* v) { return make_uint4(pack2(v[0], v[1]), pack2(v[2], v[3]), pack2(v[4], v[5]), pack2(v[6], v[7])); }
DI void unpack8(uint4 u, float* v) {
  v[0] = bflo(u.x); v[1] = bfhi(u.x); v[2] = bflo(u.y); v[3] = bfhi(u.y);
  v[4] = bflo(u.z); v[5] = bfhi(u.z); v[6] = bflo(u.w); v[7] = bfhi(u.w);
}
DI int crow(int reg, int h) { return (reg & 3) + 8 * (reg >> 2) + 4 * h; }
DI float wave_sum(float v) {
#pragma unroll
  for (int o = 32; o >= 1; o >>= 1) v += __shfl_xor(v, o);
  return v;
}

constexpr int GST = 144;
constexpr int EST = 132;
constexpr int LDS_BYTES = 3 * 24576 + 16;

constexpr int GROW = 64;
constexpr int GSTG = 384 * GROW;
#define WAIT_VM(n) asm volatile("s_waitcnt vmcnt(" #n ")" ::: "memory")
#define GLDS16(g, l) __builtin_amdgcn_global_load_lds((const unsigned*)(g), (unsigned*)(l), 16, 0, 0)

template <class Epi>
DI void gemm_tile(const bf16_t* A, const unsigned (&a_off)[4], const bf16_t* B0, const bf16_t* B1, int ldb, int K,
                  unsigned char* smem, const Epi& epi) {
  const int tid = threadIdx.x, lane = tid & 63, wave = tid >> 6;
  const int wm = wave >> 1, wn = wave & 1;
  const int lrow = tid >> 2, kc = tid & 3;
  const int ql = lane & 31, h = lane >> 5;
  f32x16 acc[4][2];
#pragma unroll
  for (int mi = 0; mi < 4; ++mi)
#pragma unroll
    for (int ni = 0; ni < 2; ++ni)
#pragma unroll
      for (int r = 0; r < 16; ++r) acc[mi][ni][r] = 0.f;

  const int csrc = (kc ^ ((lrow >> 2) & 3)) * 8;
  const unsigned char* Ab = (const unsigned char*)A;
  const unsigned char* bp0 = (const unsigned char*)(B0 + (size_t)lrow * ldb + csrc);
  const unsigned char* bp1 = (const unsigned char*)(B1 + (size_t)lrow * ldb + csrc);
  unsigned ao[4];
#pragma unroll
  for (int i = 0; i < 4; ++i) ao[i] = (a_off[i] + csrc) * 2u;
  unsigned char* dbase = smem + wave * 1024;
  const int nk = K >> 5;
  WAIT_VM(0);
  __syncthreads();
  {
#pragma unroll
    for (int i = 0; i < 4; ++i) GLDS16(Ab + ao[i], dbase + i * 4096);
    GLDS16(bp0, dbase + 16384); GLDS16(bp1, dbase + 20480);
    const unsigned kb = (nk > 1) ? 64u : 0u;
#pragma unroll
    for (int i = 0; i < 4; ++i) GLDS16(Ab + ao[i] + kb, dbase + GSTG + i * 4096);
    GLDS16(bp0 + kb, dbase + GSTG + 16384); GLDS16(bp1 + kb, dbase + GSTG + 20480);
  }
  const int sw = (ql >> 2) & 3;
  const int o0 = ((0 + h) ^ sw) * 16, o1 = ((2 + h) ^ sw) * 16;
  const int aoffr = (wm * 128 + ql) * GROW;
  const int boffr = 256 * GROW + (wn * 64 + ql) * GROW;
  int cs = 0, ns = 2;
#pragma unroll 1
  for (int kt = 0; kt < nk; ++kt) {
    WAIT_VM(6);
    asm volatile("s_waitcnt lgkmcnt(0)" ::: "memory");
    __builtin_amdgcn_s_barrier();
    const unsigned char* cur = smem + cs * GSTG;
    unsigned char* nd = dbase + ns * GSTG;
    const unsigned kb = (unsigned)min(kt + 2, nk - 1) * 64u;
#pragma unroll
    for (int i = 0; i < 4; ++i) GLDS16(Ab + ao[i] + kb, nd + i * 4096);
    GLDS16(bp0 + kb, nd + 16384); GLDS16(bp1 + kb, nd + 20480);
    bf16x8 af0[4], bf0[2], af1[4], bf1[2];
#pragma unroll
    for (int mi = 0; mi < 4; ++mi) af0[mi] = *(const bf16x8*)(cur + aoffr + mi * 32 * GROW + o0);
#pragma unroll
    for (int ni = 0; ni < 2; ++ni) bf0[ni] = *(const bf16x8*)(cur + boffr + ni * 32 * GROW + o0);
#pragma unroll
    for (int mi = 0; mi < 4; ++mi) af1[mi] = *(const bf16x8*)(cur + aoffr + mi * 32 * GROW + o1);
#pragma unroll
    for (int ni = 0; ni < 2; ++ni) bf1[ni] = *(const bf16x8*)(cur + boffr + ni * 32 * GROW + o1);
#pragma unroll
    for (int mi = 0; mi < 4; ++mi)
#pragma unroll
      for (int ni = 0; ni < 2; ++ni) acc[mi][ni] = MFMA32(af0[mi], bf0[ni], acc[mi][ni]);
#pragma unroll
    for (int mi = 0; mi < 4; ++mi)
#pragma unroll
      for (int ni = 0; ni < 2; ++ni) acc[mi][ni] = MFMA32(af1[mi], bf1[ni], acc[mi][ni]);
    __builtin_amdgcn_sched_group_barrier(0x100, 6, 0);
#pragma unroll
    for (int i = 0; i < 6; ++i) {
      __builtin_amdgcn_sched_group_barrier(0x008, 1, 0);
      __builtin_amdgcn_sched_group_barrier(0x100, 1, 0);
    }
    __builtin_amdgcn_sched_group_barrier(0x008, 10, 0);
    cs = (cs == 2) ? 0 : cs + 1;
    ns = (ns == 2) ? 0 : ns + 1;
  }
  WAIT_VM(0);
  __syncthreads();
  float* st = (float*)smem;
  int tl = tid;
  asm volatile("" : "+v"(tl));
#pragma unroll
  for (int q = 0; q < 4; ++q) {
    if (wm == (q >> 1)) {
#pragma unroll
      for (int m2 = 0; m2 < 2; ++m2)
#pragma unroll
        for (int ni = 0; ni < 2; ++ni)
#pragma unroll
          for (int r = 0; r < 16; ++r)
            st[(m2 * 32 + crow(r, h)) * EST + wn * 64 + ni * 32 + ql] = acc[(q & 1) * 2 + m2][ni][r];
    }
    __syncthreads();
    epi.process(st, q, tl);
    __syncthreads();
  }
}

struct EpiStore {
  bf16_t* dst;
  int ld;
  const float* colscale;
  const float* rowscale;
  int cmode;
  DI void process(const float* st, int hm, int tid) const {
    if (cmode != 0) {
#pragma unroll
      for (int i = 0; i < 2; ++i) {
        const int c = tid + 256 * i, r = c >> 3, cc = c & 7;
        const float4 a0 = *(const float4*)(st + r * EST + cc * 8), a1 = *(const float4*)(st + r * EST + cc * 8 + 4);
        const float4 b0 = *(const float4*)(st + r * EST + 64 + cc * 8), b1 = *(const float4*)(st + r * EST + 64 + cc * 8 + 4);
        float a[8] = {a0.x, a0.y, a0.z, a0.w, a1.x, a1.y, a1.z, a1.w};
        const float b[8] = {b0.x, b0.y, b0.z, b0.w, b1.x, b1.y, b1.z, b1.w};
        if (cmode == 1) {
#pragma unroll
          for (int j = 0; j < 8; ++j) a[j] = a[j] / (1.f + __expf(-a[j])) * b[j];
        } else {
#pragma unroll
          for (int j = 0; j < 8; ++j) a[j] = a[j] * b[j];
        }
        *(uint4*)(dst + (size_t)(hm * 64 + r) * ld + cc * 8) = pack8(a);
      }
      return;
    }
#pragma unroll
    for (int i = 0; i < 4; ++i) {
      const int c = tid + 256 * i, r = c >> 4, cc = c & 15;
      const float4 a = *(const float4*)(st + r * EST + cc * 8);
      const float4 b = *(const float4*)(st + r * EST + cc * 8 + 4);
      float v[8] = {a.x, a.y, a.z, a.w, b.x, b.y, b.z, b.w};
      const int row = hm * 64 + r;
      if (rowscale) { const float rs = rowscale[row];
#pragma unroll
        for (int j = 0; j < 8; ++j) v[j] *= rs; }
      if (colscale) {
#pragma unroll
        for (int j = 0; j < 8; ++j) v[j] *= colscale[cc * 8 + j]; }
      *(uint4*)(dst + (size_t)row * ld + cc * 8) = pack8(v);
    }
  }
};

struct EpiInProj {
  unsigned char* ws;
  const float *qg, *kg;
  int row0;
  int is_ctx;
  int ct;
  DI void process(const float* st, int hm, int tid) const {
    if (ct == 5) {
      bf16_t* Vt = (bf16_t*)(ws + OFF_VT);
#pragma unroll
      for (int i = 0; i < 4; ++i) {
        const int c = tid + 256 * i, d = c >> 3, rc = c & 7;
        float v[8];
#pragma unroll
        for (int j = 0; j < 8; ++j) v[j] = st[(rc * 8 + j) * EST + d];
        const int r = row0 + hm * 64 + rc * 8;
        const int b = is_ctx ? (r >> 8) : (r >> 12);
        const int key = is_ctx ? (r & 255) : (CTXL + (r & 4095));
        *(uint4*)(Vt + ((size_t)((b * 2 + (d >> 6)) * 64 + (d & 63))) * NKEY + key) = pack8(v);
      }
      return;
    }
    const float* cos_t = (const float*)(ws + OFF_ROPE);
    const float* sin_t = cos_t + 1024;
#pragma unroll
    for (int i = 0; i < 4; ++i) {
      const int c = tid + 256 * i, r = c >> 4, cc = c & 15;
      const float4 a = *(const float4*)(st + r * EST + cc * 8);
      const float4 bb = *(const float4*)(st + r * EST + cc * 8 + 4);
      float v[8] = {a.x, a.y, a.z, a.w, bb.x, bb.y, bb.z, bb.w};
      const int grow = row0 + hm * 64 + r;
      if (ct <= 4) {
        float ss = 0.f;
#pragma unroll
        for (int j = 0; j < 8; ++j) ss += v[j] * v[j];
        ss += __shfl_xor(ss, 1); ss += __shfl_xor(ss, 2); ss += __shfl_xor(ss, 4);
        const float rinv = rsqrtf(ss * (1.f / 64.f) + LN_EPS);
        const float* g = (ct < 4 ? qg : kg) + (cc & 7) * 8;
#pragma unroll
        for (int j = 0; j < 8; ++j) v[j] = v[j] * rinv * g[j];
        if (!is_ctx) {
          const int t = grow & 4095, rowp = t >> 6, colp = t & 63;
#pragma unroll
          for (int jj = 0; jj < 4; ++jj) {
            const int pidx = (cc & 7) * 4 + jj;
            const int pos = (pidx < 16) ? rowp : colp;
            const float cs = cos_t[pos * 16 + (pidx & 15)], sn = sin_t[pos * 16 + (pidx & 15)];
            const float x0 = v[2 * jj], x1 = v[2 * jj + 1];
            v[2 * jj] = x0 * cs - x1 * sn;
            v[2 * jj + 1] = x0 * sn + x1 * cs;
          }
        }
        if (ct < 4) {
#pragma unroll
          for (int j = 0; j < 8; ++j) v[j] *= QSCALE;
          *(uint4*)((bf16_t*)(ws + OFF_Q) + (size_t)grow * 512 + ct * 128 + cc * 8) = pack8(v);
        } else {
          const int b = is_ctx ? (grow >> 8) : (grow >> 12);
          const int key = is_ctx ? (grow & 255) : (CTXL + (grow & 4095));
          *(uint4*)((bf16_t*)(ws + OFF_K) + ((size_t)(b * 2 + (cc >> 3)) * NKEY + key) * 64 + (cc & 7) * 8) = pack8(v);
        }
      } else {
        *(uint4*)((bf16_t*)(ws + OFF_P) + (size_t)grow * 512 + (ct - 6) * 128 + cc * 8) = pack8(v);
      }
    }
  }
};

DI void cvt_tile(const float* __restrict__ src, bf16_t* dst, int K, int N, int kt, int nt, float* st) {
  const int tid = threadIdx.x;
  const int k0 = kt * 64, n0 = nt * 64;
  __syncthreads();
#pragma unroll
  for (int i = 0; i < 4; ++i) {
    const int k = (tid >> 4) + 16 * i, n4 = (tid & 15) * 4;
    const f32x4 v = __builtin_nontemporal_load((const f32x4*)(src + (size_t)(k0 + k) * N + n0 + n4));
    st[k * 65 + n4 + 0] = v.x; st[k * 65 + n4 + 1] = v.y; st[k * 65 + n4 + 2] = v.z; st[k * 65 + n4 + 3] = v.w;
  }
  __syncthreads();
#pragma unroll
  for (int i = 0; i < 2; ++i) {
    const int c = tid + 256 * i, n = c >> 3, kc = c & 7;
    float v[8];
#pragma unroll
    for (int j = 0; j < 8; ++j) v[j] = st[(kc * 8 + j) * 65 + n];
    *(uint4*)(dst + (size_t)(n0 + n) * K + k0 + kc * 8) = pack8(v);
  }
}

DI void modgemv_item(const Params& p, int item, float* sm) {
  const int tid = threadIdx.x, lane = tid & 63, wave = tid >> 6;
  const int l = item / 96, n0 = (item % 96) * 64;
  float* red = sm + 5120;
  __syncthreads();
  for (int i = tid; i < 5120; i += 256) {
    const int r = i >> 10, k = i & 1023;
    const float cv = (r < 4) ? p.c[r * 1024 + k] : p.c_ctx[k];
    sm[i] = cv / (1.f + expf(-cv));
  }
  __syncthreads();
  const int sub = lane >> 4, c4 = (lane & 15) * 4;
  f32x4 a0 = {0.f, 0.f, 0.f, 0.f}, a1 = a0, a2 = a0, a3 = a0, a4 = a0;
  const float* w = p.w_mod + (size_t)l * 1024 * 6144 + n0 + c4;
  const int kb = wave * 256 + sub;
#pragma unroll 8
  for (int kk = 0; kk < 64; ++kk) {
    const int k = kb + kk * 4;
    const f32x4 wv = __builtin_nontemporal_load((const f32x4*)(w + (size_t)k * 6144));
    a0 += sm[k] * wv; a1 += sm[1024 + k] * wv; a2 += sm[2048 + k] * wv; a3 += sm[3072 + k] * wv; a4 += sm[4096 + k] * wv;
  }
#pragma unroll
  for (int j = 0; j < 4; ++j) {
    a0[j] += __shfl_xor(a0[j], 16); a0[j] += __shfl_xor(a0[j], 32);
    a1[j] += __shfl_xor(a1[j], 16); a1[j] += __shfl_xor(a1[j], 32);
    a2[j] += __shfl_xor(a2[j], 16); a2[j] += __shfl_xor(a2[j], 32);
    a3[j] += __shfl_xor(a3[j], 16); a3[j] += __shfl_xor(a3[j], 32);
    a4[j] += __shfl_xor(a4[j], 16); a4[j] += __shfl_xor(a4[j], 32);
  }
  if (sub == 0) {
    *(f32x4*)(red + (wave * 5 + 0) * 64 + c4) = a0; *(f32x4*)(red + (wave * 5 + 1) * 64 + c4) = a1; *(f32x4*)(red + (wave * 5 + 2) * 64 + c4) = a2;
    *(f32x4*)(red + (wave * 5 + 3) * 64 + c4) = a3; *(f32x4*)(red + (wave * 5 + 4) * 64 + c4) = a4;
  }
  __syncthreads();
  float* modv = (float*)(p.ws + OFF_MOD);
  for (int o = tid; o < 320; o += 256) {
    const int r = o >> 6, ln = o & 63;
    float s = p.b_mod[l * 6144 + n0 + ln];
#pragma unroll
    for (int w4 = 0; w4 < 4; ++w4) s += red[(w4 * 5 + r) * 64 + ln];
    modv[(size_t)(l * 5 + r) * 6144 + n0 + ln] = s;
  }
}

DI void phase_prologue(const Params& p, unsigned char* smem) {
  constexpr int N_GEMV = 192, N_ROPE = 1;
  constexpr int T_IN = 16 * 20, T_POOL = 16, T_OUT = 256, T_CIN = 16 * 48, T_COUT = 256, T_EXP = 8192;
  constexpr int total = N_GEMV + N_ROPE + T_IN + T_POOL + T_OUT;
  float* sm = (float*)smem;
  for (int it = blockIdx.x; it < total; it += gridDim.x) {
    int t = it;
    if (t < N_GEMV) { modgemv_item(p, t, sm); continue; }
    t -= N_GEMV;
    if (t < N_ROPE) {
      float* cos_t = (float*)(p.ws + OFF_ROPE);
      for (int i = threadIdx.x; i < 1024; i += 256) {
        const int pos = i >> 4, fi = i & 15;
        const float inv = exp2f(-(float)fi * (13.287712379549449f / 16.f));
        const float ang = (float)pos * inv;
        cos_t[i] = cosf(ang); cos_t[1024 + i] = sinf(ang);
      }
      continue;
    }
    t -= N_ROPE;
    if (t < T_IN) { cvt_tile(p.w_mix_in, (bf16_t*)(p.ws + OFF_WT_IN), 1024, 1280, t / 20, t % 20, sm); continue; }
    t -= T_IN;
    if (t < T_POOL) { const int g = t >> 2, r = t & 3;
      cvt_tile(p.w_pool_grp + g * 16384, (bf16_t*)(p.ws + OFF_WT_POOL) + g * 16384, 128, 128, r >> 1, r & 1, sm); continue; }
    t -= T_POOL;
    cvt_tile(p.w_mix_out, (bf16_t*)(p.ws + OFF_WT_OUT), 1024, 1024, t >> 4, t & 15, sm);
  }
}

constexpr int N_LATE = 768 + 256 + 3 * 8192;
DI void cvt_late_tile(const Params& p, int t, float* sm) {
  if (t < 768) { cvt_tile(p.w_conv_in, (bf16_t*)(p.ws + OFF_WT_CIN), 1024, 3072, t / 48, t % 48, sm); return; }
  t -= 768;
  if (t < 256) { cvt_tile(p.w_conv_out, (bf16_t*)(p.ws + OFF_WT_COUT), 1024, 1024, t >> 4, t & 15, sm); return; }
  t -= 256;
  const int which = t >> 13, r = t & 8191, mat = r >> 8, tt = r & 255;
  const float* src = (which == 0 ? p.w_exp_gate : which == 1 ? p.w_exp_up : p.w_exp_down) + (size_t)mat * 1048576;
  bf16_t* dst = (bf16_t*)(p.ws + (which == 0 ? OFF_WT_G : which == 1 ? OFF_WT_U : OFF_WT_D)) + (size_t)mat * 1048576;
  cvt_tile(src, dst, 1024, 1024, tt >> 4, tt & 15, sm);
}
struct CvtDesc { const float* src; bf16_t* dst; int K, N, k0, n0; };
DI CvtDesc cvt_late_desc(const Params& p, int t) {
  CvtDesc d;
  if (t < 768) { d.src = p.w_conv_in; d.dst = (bf16_t*)(p.ws + OFF_WT_CIN); d.K = 1024; d.N = 3072; d.k0 = (t / 48) * 64; d.n0 = (t % 48) * 64; return d; }
  t -= 768;
  if (t < 256) { d.src = p.w_conv_out; d.dst = (bf16_t*)(p.ws + OFF_WT_COUT); d.K = 1024; d.N = 1024; d.k0 = (t >> 4) * 64; d.n0 = (t & 15) * 64; return d; }
  t -= 256;
  const int which = t >> 13, r = t & 8191, mat = r >> 8, tt = r & 255;
  d.src = (which == 0 ? p.w_exp_gate : which == 1 ? p.w_exp_up : p.w_exp_down) + (size_t)mat * 1048576;
  d.dst = (bf16_t*)(p.ws + (which == 0 ? OFF_WT_G : which == 1 ? OFF_WT_U : OFF_WT_D)) + (size_t)mat * 1048576;
  d.K = 1024; d.N = 1024; d.k0 = (tt >> 4) * 64; d.n0 = (tt & 15) * 64;
  return d;
}
DI int late_n_idle() { return 0; }
DI int late_n_early() { return min(14 * late_n_idle(), N_LATE); }
DI void cvt_late_range(const Params& p, int i0, int i1, float* sm) {
  const int base = late_n_early();
  for (int i = i0; i < i1; ++i) { const int t = base + blockIdx.x + i * gridDim.x; if (t < N_LATE) cvt_late_tile(p, t, sm); }
}

DI void phase_mod_input(const Params& p) {
  const float* modv = (const float*)(p.ws + OFF_MOD);
  bf16_t* uA = (bf16_t*)(p.ws + OFF_UA);
  bf16_t* uC = (bf16_t*)(p.ws + OFF_UCTX);
  const int total = (NTOK + NCTX) * 128;
  for (int i = blockIdx.x * 256 + threadIdx.x; i < total; i += gridDim.x * 256) {
    const int row = i >> 7, c8 = (i & 127) * 8;
    const float* src; bf16_t* dst; int mr;
    if (row < NTOK) { src = p.x + (size_t)row * D + c8; dst = uA + (size_t)row * D + c8; mr = row >> 12; }
    else { const int r = row - NTOK; src = p.ctx + (size_t)r * D + c8; dst = uC + (size_t)r * D + c8; mr = 4; }
    const float* sh = modv + (size_t)mr * 6144 + c8;
    const float* sc = sh + 1024;
    const f32x4 a = __builtin_nontemporal_load((const f32x4*)src), b = __builtin_nontemporal_load((const f32x4*)(src + 4));
    const float4 s0 = *(const float4*)sh, s1 = *(const float4*)(sh + 4);
    const float4 c0 = *(const float4*)sc, c1 = *(const float4*)(sc + 4);
    float v[8] = {a.x * (1.f + c0.x) + s0.x, a.y * (1.f + c0.y) + s0.y, a.z * (1.f + c0.z) + s0.z, a.w * (1.f + c0.w) + s0.w,
                  b.x * (1.f + c1.x) + s1.x, b.y * (1.f + c1.y) + s1.y, b.z * (1.f + c1.z) + s1.z, b.w * (1.f + c1.w) + s1.w};
    *(uint4*)dst = pack8(v);
  }
}

#define XCD_LOOP(k, n_x) const int x = blockIdx.x & 7, nper_ = gridDim.x >> 3; for (int k = blockIdx.x >> 3; k < (n_x); k += nper_)

DI void phase_inproj(const Params& p, unsigned char* smem) {
  const bf16_t* Wt = (const bf16_t*)(p.ws + OFF_WT_IN);
  const int lrow = threadIdx.x >> 2;
  XCD_LOOP(k, 81) {
    EpiInProj e; e.ws = p.ws; e.qg = p.q_norm_g; e.kg = p.k_norm_g;
    const bf16_t* A; int rt, ct;
    if (k < 80) { rt = 8 * x + k / 10; ct = k % 10; A = (const bf16_t*)(p.ws + OFF_UA); e.is_ctx = 0; }
    else { rt = x >> 1; ct = 4 + (x & 1); A = (const bf16_t*)(p.ws + OFF_UCTX); e.is_ctx = 1; }
    e.row0 = rt * 256; e.ct = ct;
    unsigned a_off[4];
#pragma unroll
    for (int i = 0; i < 4; ++i) a_off[i] = (unsigned)(rt * 256 + lrow + 64 * i) * D;
    const bf16_t* B = Wt + (size_t)ct * 128 * D;
    gemm_tile(A, a_off, B, B + (size_t)64 * D, D, D, smem, e);
  }
  {
    const int nper = gridDim.x >> 3, j = blockIdx.x >> 3, n_idle = late_n_idle();
    if (n_idle > 0 && j >= 17) {
      const int rank = (blockIdx.x & 7) * (nper - 17) + (j - 17), n_early = late_n_early();
      for (int t = rank; t < n_early; t += n_idle) cvt_late_tile(p, t, (float*)smem);
    }
  }
}

template <int HW>
DI void pooled_one(const bf16_t* __restrict__ P, bf16_t* __restrict__ PO, int row, int c8) {
  const int t = row & 4095, base = row - t;
  u32x4 v[2 * HW];
#pragma unroll
  for (int k = 0; k < 2 * HW; ++k) {
    const int sc = min(max(t - HW + k, 0), S - 1);
    v[k] = *(const u32x4*)(P + (size_t)(base + sc) * 512 + c8);
  }
  float acc[8] = {0.f, 0.f, 0.f, 0.f, 0.f, 0.f, 0.f, 0.f};
#pragma unroll
  for (int k = 0; k < 2 * HW; ++k) {
    const int sr = t - HW + k;
    const float w = (sr >= 0 && sr < S) ? 1.f : 0.f;
    acc[0] += w * bflo(v[k].x); acc[1] += w * bfhi(v[k].x); acc[2] += w * bflo(v[k].y); acc[3] += w * bfhi(v[k].y);
    acc[4] += w * bflo(v[k].z); acc[5] += w * bfhi(v[k].z); acc[6] += w * bflo(v[k].w); acc[7] += w * bfhi(v[k].w);
  }
  const float rc = 1.f / (float)(min(t + HW, S) - max(t - HW, 0));
  const u32x4 sv = v[HW];
  float o[8] = {acc[0] * rc - bflo(sv.x), acc[1] * rc - bfhi(sv.x), acc[2] * rc - bflo(sv.y), acc[3] * rc - bfhi(sv.y),
                acc[4] * rc - bflo(sv.z), acc[5] * rc - bfhi(sv.z), acc[6] * rc - bflo(sv.w), acc[7] * rc - bfhi(sv.w)};
  *(uint4*)(PO + (size_t)row * 512 + c8) = pack8(o);
}
DI void phase_pooled(const Params& p) {
  const bf16_t* P = (const bf16_t*)(p.ws + OFF_P);
  bf16_t* PO = (bf16_t*)(p.ws + OFF_POOLED);
  const int total = NTOK * 64;
  for (int i = blockIdx.x * 256 + threadIdx.x; i < total; i += gridDim.x * 256) {
    const int lane = i & 63, wq = i >> 6, g = wq & 3, row = (wq >> 2) * 4 + (lane >> 4), c8 = g * 128 + (lane & 15) * 8;
    if (g == 0) pooled_one<1>(P, PO, row, c8);
    else if (g == 1) pooled_one<2>(P, PO, row, c8);
    else if (g == 2) pooled_one<4>(P, PO, row, c8);
    else pooled_one<8>(P, PO, row, c8);
  }
}

constexpr int AK_ST = 144, AV_ST = 136;
constexpr int ABUF = 64 * AK_ST + 64 * AV_ST;

constexpr int CVT_R0 = 36864, CVT_RSZ = 16384;
DI int late_tile_of(int i) { const int t = late_n_early() + (int)blockIdx.x + i * (int)gridDim.x; return (t < N_LATE) ? t : -1; }
DI void cvt_dma_issue(const Params& p, int t, unsigned char* reg, int tid) {
  const CvtDesc d = cvt_late_desc(p, t);
  const int lane = tid & 63, wave = tid >> 6;
#pragma unroll
  for (int i = 0; i < 4; ++i) {
    const int k = (i * 4 + wave) * 4 + (lane >> 4), pos = lane & 15;
    const float* g = d.src + (size_t)(d.k0 + k) * d.N + d.n0 + ((pos ^ ((k >> 3) & 7)) << 2);
    __builtin_amdgcn_global_load_lds((const unsigned*)g, (unsigned*)(reg + (i * 4 + wave) * 1024), 16, 0, 2);
  }
}
DI void cvt_lds_store(const Params& p, int t, const unsigned char* reg, int tid) {
  const CvtDesc d = cvt_late_desc(p, t);
  const float* R = (const float*)reg;
#pragma unroll
  for (int i = 0; i < 2; ++i) {
    const int c = tid + 256 * i, n = c >> 3, kc = c & 7;
    float v[8];
#pragma unroll
    for (int jj = 0; jj < 8; ++jj) v[jj] = R[(kc * 8 + jj) * 64 + ((((n >> 2) ^ kc) & 15) << 2) + (n & 3)];
    const uint4 o4 = pack8(v);
    __builtin_nontemporal_store((u32x4){o4.x, o4.y, o4.z, o4.w}, (u32x4*)(d.dst + (size_t)(d.n0 + n) * d.K + d.k0 + kc * 8));
  }
}

DI void attn_item(const Params& p, int item, unsigned char* smem, int cvt_i0, int cvt_n) {
  int tid_ = threadIdx.x;
  asm volatile("" : "+v"(tid_));
  const int tid = tid_, lane = tid & 63, wave = tid >> 6, ql = lane & 31, h = lane >> 5;
  const int qb = item & 15, head = (item >> 4) & 7, b = item >> 7, kvh = head >> 2;
  const int tok0 = b * S + qb * 256 + wave * 64 + ql;
  bf16x8 qf[2][4];
#pragma unroll
  for (int g = 0; g < 2; ++g) {
    const bf16_t* Qp = (const bf16_t*)(p.ws + OFF_Q) + (size_t)(tok0 + g * 32) * 512 + head * 64;
#pragma unroll
    for (int s = 0; s < 4; ++s) qf[g][s] = *(const bf16x8*)(Qp + s * 16 + h * 8);
  }
  const bf16_t* Kg = (const bf16_t*)(p.ws + OFF_K) + (size_t)(b * 2 + kvh) * NKEY * 64;
  const bf16_t* Vg = (const bf16_t*)(p.ws + OFF_VT) + (size_t)(b * 2 + kvh) * 64 * NKEY;
  const int lr = tid >> 3, kc = tid & 7;
  const bf16_t* kp = Kg + (size_t)lr * 64 + kc * 8;
  const bf16_t* vp = Vg + (size_t)lr * NKEY + kc * 8;
  u32x4 rk0 = *(const u32x4*)kp, rk1 = *(const u32x4*)(kp + 32 * 64);
  u32x4 rv0 = *(const u32x4*)vp, rv1 = *(const u32x4*)(vp + (size_t)32 * NKEY);
  const int wko = lr * AK_ST + kc * 16, wvo = 64 * AK_ST + lr * AV_ST + kc * 16;
  __syncthreads();
  {
    unsigned char* wk = smem + wko; unsigned char* wv = smem + wvo;
    *(u32x4*)wk = rk0; *(u32x4*)(wk + 32 * AK_ST) = rk1;
    *(u32x2*)wv = rv0.xy; *(u32x2*)(wv + 8) = rv0.zw; *(u32x2*)(wv + 32 * AV_ST) = rv1.xy; *(u32x2*)(wv + 32 * AV_ST + 8) = rv1.zw;
  }
  __syncthreads();
  f32x16 o[2][2];
#pragma unroll
  for (int r = 0; r < 16; ++r) { o[0][0][r] = 0.f; o[0][1][r] = 0.f; o[1][0][r] = 0.f; o[1][1][r] = 0.f; }
  float m_old[2] = {-1e30f, -1e30f}, lsum[2] = {0.f, 0.f};
  constexpr int NT = NKEY / 64;
  for (int j = 0; j < NT; ++j) {
    const unsigned char* sK = smem + (j & 1) * ABUF;
    const unsigned char* sV = sK + 64 * AK_ST;
    int tid2 = tid;
    asm volatile("" : "+v"(tid2));
    if (j < cvt_n) { const int t = late_tile_of(cvt_i0 + j); if (t >= 0) cvt_dma_issue(p, t, smem + CVT_R0 + (j & 1) * CVT_RSZ, tid2); }
    if (j >= 1 && j <= cvt_n) { const int t = late_tile_of(cvt_i0 + j - 1); if (t >= 0) cvt_lds_store(p, t, smem + CVT_R0 + ((j - 1) & 1) * CVT_RSZ, tid2); }
    __builtin_amdgcn_sched_barrier(0);
    if (j + 1 < NT) {
      const int key0 = (j + 1) * 64;
      rk0 = *(const u32x4*)(kp + (size_t)key0 * 64); rk1 = *(const u32x4*)(kp + (size_t)(key0 + 32) * 64);
      rv0 = *(const u32x4*)(vp + key0); rv1 = *(const u32x4*)(vp + (size_t)32 * NKEY + key0);
    }
    f32x16 st[2][2];
#pragma unroll
    for (int g = 0; g < 2; ++g)
#pragma unroll
      for (int kt = 0; kt < 2; ++kt)
#pragma unroll
        for (int r = 0; r < 16; ++r) st[g][kt][r] = 0.f;
#pragma unroll
    for (int kt = 0; kt < 2; ++kt)
#pragma unroll
      for (int s = 0; s < 4; ++s) {
        const bf16x8 kf = *(const bf16x8*)(sK + (kt * 32 + ql) * AK_ST + s * 32 + h * 16);
        st[0][kt] = MFMA32(kf, qf[0][s], st[0][kt]);
        st[1][kt] = MFMA32(kf, qf[1][s], st[1][kt]);
      }
#pragma unroll
    for (int g = 0; g < 2; ++g) {
      float mx = st[g][0][0];
#pragma unroll
      for (int r = 0; r < 16; ++r) { mx = fmaxf(mx, st[g][0][r]); mx = fmaxf(mx, st[g][1][r]); }
      mx = fmaxf(mx, __shfl_xor(mx, 32));
      const float m_new = fmaxf(m_old[g], mx);
      if (__any(m_new > m_old[g])) {
        const float alpha = __builtin_amdgcn_exp2f(m_old[g] - m_new);
        m_old[g] = m_new;
        o[g][0] = o[g][0] * alpha; o[g][1] = o[g][1] * alpha; lsum[g] *= alpha;
      }
      st[g][0] = st[g][0] - m_old[g]; st[g][1] = st[g][1] - m_old[g];
#pragma unroll
      for (int kt = 0; kt < 2; ++kt)
#pragma unroll
        for (int r = 0; r < 16; ++r) { st[g][kt][r] = __builtin_amdgcn_exp2f(st[g][kt][r]); lsum[g] += st[g][kt][r]; }
    }
#pragma unroll
    for (int kt = 0; kt < 2; ++kt)
#pragma unroll
      for (int s2 = 0; s2 < 2; ++s2) {
        bf16x8 pf[2];
#pragma unroll
        for (int g = 0; g < 2; ++g) {
          uint4 pk = make_uint4(pack2(st[g][kt][8 * s2 + 0], st[g][kt][8 * s2 + 1]), pack2(st[g][kt][8 * s2 + 2], st[g][kt][8 * s2 + 3]),
                                pack2(st[g][kt][8 * s2 + 4], st[g][kt][8 * s2 + 5]), pack2(st[g][kt][8 * s2 + 6], st[g][kt][8 * s2 + 7]));
          pf[g] = __builtin_bit_cast(bf16x8, pk);
        }
#pragma unroll
        for (int dt = 0; dt < 2; ++dt) {
          const unsigned char* va = sV + (dt * 32 + ql) * AV_ST + (kt * 32 + 16 * s2 + 4 * h) * 2;
          const uint2 lo = *(const uint2*)va, hi = *(const uint2*)(va + 16);
          const uint4 vv = make_uint4(lo.x, lo.y, hi.x, hi.y);
          const bf16x8 vf = __builtin_bit_cast(bf16x8, vv);
          o[0][dt] = MFMA32(vf, pf[0], o[0][dt]);
          o[1][dt] = MFMA32(vf, pf[1], o[1][dt]);
        }
      }
    if (j + 1 < NT) {
      unsigned char* wk = smem + ((j + 1) & 1) * ABUF + wko; unsigned char* wv = smem + ((j + 1) & 1) * ABUF + wvo;
      *(u32x4*)wk = rk0; *(u32x4*)(wk + 32 * AK_ST) = rk1;
      *(u32x2*)wv = rv0.xy; *(u32x2*)(wv + 8) = rv0.zw; *(u32x2*)(wv + 32 * AV_ST) = rv1.xy; *(u32x2*)(wv + 32 * AV_ST + 8) = rv1.zw;
    }
    asm volatile("s_waitcnt vmcnt(0)" ::: "memory");
    __syncthreads();
  }
  int tokl = b * S + qb * 256 + wave * 64 + ql;
  asm volatile("" : "+v"(tokl));
#pragma unroll
  for (int g = 0; g < 2; ++g) {
    const float lt = lsum[g] + __shfl_xor(lsum[g], 32);
    const float il = 1.f / lt;
    bf16_t* Op = (bf16_t*)(p.ws + OFF_CAT) + (size_t)(tokl + g * 32) * 1024 + head * 64;
#pragma unroll
    for (int dt = 0; dt < 2; ++dt)
#pragma unroll
      for (int q4 = 0; q4 < 4; ++q4) {
        const uint2 w2 = make_uint2(pack2(o[g][dt][4 * q4] * il, o[g][dt][4 * q4 + 1] * il), pack2(o[g][dt][4 * q4 + 2] * il, o[g][dt][4 * q4 + 3] * il));
        *(uint2*)(Op + dt * 32 + 8 * q4 + 4 * h) = w2;
      }
  }
}

DI void phase_attn_pool(const Params& p, unsigned char* smem) {
  constexpr int N_ATT = NB_ * 8 * 16, N_POOL = 64 * 4;
  const int x = blockIdx.x & 7, j = blockIdx.x >> 3, nper = gridDim.x >> 3;
  const int n_i = (N_LATE - late_n_early() + gridDim.x - 1) / gridDim.x;
  float* sm = (float*)smem;
  int done = 0;
  for (int k = j; k < N_ATT / 8; k += nper) {
    const int take = min(n_i - done, 67);
    attn_item(p, (x >> 1) * 128 + ((x & 1) * 4 + (k >> 4)) * 16 + (k & 15), smem, done, take);
    done += take;
  }
  cvt_late_range(p, done, n_i, sm);
  int tidl = threadIdx.x;
  asm volatile("" : "+v"(tidl));
  const int lrow = tidl >> 2;
  for (int k = j; k < N_POOL / 8; k += nper) {
    const int t = k * 8 + x, rt = t >> 2, g = t & 3;
    {
      const bf16_t* P = (const bf16_t*)(p.ws + OFF_P);
      bf16_t* PO = (bf16_t*)(p.ws + OFF_POOLED);
#pragma unroll 1
      for (int i = 0; i < 16; ++i) {
        const int idx = tidl + 256 * i, row = rt * 256 + (idx >> 4), c8 = g * 128 + (idx & 15) * 8;
        if (g == 0) pooled_one<1>(P, PO, row, c8);
        else if (g == 1) pooled_one<2>(P, PO, row, c8);
        else if (g == 2) pooled_one<4>(P, PO, row, c8);
        else pooled_one<8>(P, PO, row, c8);
      }
      asm volatile("s_waitcnt vmcnt(0)" ::: "memory");
      __syncthreads();
    }
    unsigned a_off[4];
#pragma unroll
    for (int i = 0; i < 4; ++i) a_off[i] = (unsigned)(rt * 256 + lrow + 64 * i) * 512 + g * 128;
    const bf16_t* B = (const bf16_t*)(p.ws + OFF_WT_POOL) + g * 16384;
    EpiStore e; e.dst = (bf16_t*)(p.ws + OFF_CAT) + (size_t)rt * 256 * 1024 + 512 + g * 128; e.ld = 1024;
    e.colscale = p.pool_scale + g * 128; e.rowscale = nullptr; e.cmode = 0;
    gemm_tile((const bf16_t*)(p.ws + OFF_POOLED), a_off, B, B + 64 * 128, 128, 128, smem, e);
  }
}

DI void phase_gemm_plain(const bf16_t* A, const bf16_t* Wt, bf16_t* dst, int ncol_tiles, int ldd, unsigned char* smem) {
  const int lrow = threadIdx.x >> 2;
  XCD_LOOP(k, 8 * ncol_tiles) {
    const int rt = 8 * x + k / ncol_tiles, ct = k % ncol_tiles;
    unsigned a_off[4];
#pragma unroll
    for (int i = 0; i < 4; ++i) a_off[i] = (unsigned)(rt * 256 + lrow + 64 * i) * D;
    const bf16_t* B = Wt + (size_t)ct * 128 * D;
    EpiStore e; e.dst = dst + (size_t)rt * 256 * ldd + ct * 128; e.ld = ldd; e.colscale = nullptr; e.rowscale = nullptr; e.cmode = 0;
    gemm_tile(A, a_off, B, B + (size_t)64 * D, D, D, smem, e);
  }
}

DI void phase_ln_mix(const Params& p, int l, unsigned char* smem) {
  const int tid = threadIdx.x, lane = tid & 63, wave = tid >> 6;
  float* wrT = (float*)smem;
  __syncthreads();
  {
    const float* wr = p.w_router + (size_t)l * D * NE;
    for (int i = tid; i < D * NE / 4; i += 256) {
      const float4 v = *(const float4*)(wr + i * 4);
      const int c = i >> 2, e0 = (i & 3) * 4;
      wrT[(e0 + 0) * 1024 + c] = v.x; wrT[(e0 + 1) * 1024 + c] = v.y; wrT[(e0 + 2) * 1024 + c] = v.z; wrT[(e0 + 3) * 1024 + c] = v.w;
    }
  }
  __syncthreads();
  const float* hin = (l == 0) ? p.x : p.out;
  float* hout = (float*)(p.ws + OFF_H1);
  const bf16_t* Y = (const bf16_t*)(p.ws + OFF_Y);
  bf16_t* U = (bf16_t*)(p.ws + OFF_UA);
  float* aff = (float*)(p.ws + OFF_AFF);
  const float* modv = (const float*)(p.ws + OFF_MOD);
  const float* lg = p.ln_mix_g + l * D;
  const float* lb = p.ln_mix_b + l * D;
  const int r0 = (int)(((long long)blockIdx.x * NTOK) / gridDim.x), r1 = (int)(((long long)(blockIdx.x + 1) * NTOK) / gridDim.x);
  const int stride = 4;
  int row = r0 + wave;
  f32x4 LG[4], LB[4], GT[4], SH[4], SC[4];
#pragma unroll
  for (int i = 0; i < 4; ++i) { LG[i] = *(const f32x4*)(lg + lane * 4 + 256 * i); LB[i] = *(const f32x4*)(lb + lane * 4 + 256 * i); }
  int cur_b = -1;
  float4 hv0, hv1, hv2, hv3; u32x2 yv0, yv1, yv2, yv3;
  if (row < r1) {
    const float* hp = hin + (size_t)row * D + lane * 4; const bf16_t* yp = Y + (size_t)row * D + lane * 4;
    { const f32x4 t0_ = __builtin_nontemporal_load((const f32x4*)hp), t1_ = __builtin_nontemporal_load((const f32x4*)(hp + 256)), t2_ = __builtin_nontemporal_load((const f32x4*)(hp + 512)), t3_ = __builtin_nontemporal_load((const f32x4*)(hp + 768));
      hv0 = make_float4(t0_.x, t0_.y, t0_.z, t0_.w); hv1 = make_float4(t1_.x, t1_.y, t1_.z, t1_.w); hv2 = make_float4(t2_.x, t2_.y, t2_.z, t2_.w); hv3 = make_float4(t3_.x, t3_.y, t3_.z, t3_.w); }
    yv0 = *(const u32x2*)yp; yv1 = *(const u32x2*)(yp + 256); yv2 = *(const u32x2*)(yp + 512); yv3 = *(const u32x2*)(yp + 768);
  }
  for (; row < r1; row += stride) {
    const int b = row >> 12, t = row & 4095;
    if (b != cur_b) {
      const float* mb = modv + (size_t)(l * 5 + b) * 6144 + lane * 4;
#pragma unroll
      for (int i = 0; i < 4; ++i) { GT[i] = *(const f32x4*)(mb + 2 * 1024 + 256 * i); SH[i] = *(const f32x4*)(mb + 3 * 1024 + 256 * i); SC[i] = *(const f32x4*)(mb + 4 * 1024 + 256 * i); }
      cur_b = b;
    }
    const float4 ch[4] = {hv0, hv1, hv2, hv3};
    const u32x2 cy[4] = {yv0, yv1, yv2, yv3};
    {
      const int nrow = row + stride;
      if (nrow < r1) {
        const float* hp = hin + (size_t)nrow * D + lane * 4; const bf16_t* yp = Y + (size_t)nrow * D + lane * 4;
        { const f32x4 t0_ = __builtin_nontemporal_load((const f32x4*)hp), t1_ = __builtin_nontemporal_load((const f32x4*)(hp + 256)), t2_ = __builtin_nontemporal_load((const f32x4*)(hp + 512)), t3_ = __builtin_nontemporal_load((const f32x4*)(hp + 768));
      hv0 = make_float4(t0_.x, t0_.y, t0_.z, t0_.w); hv1 = make_float4(t1_.x, t1_.y, t1_.z, t1_.w); hv2 = make_float4(t2_.x, t2_.y, t2_.z, t2_.w); hv3 = make_float4(t3_.x, t3_.y, t3_.z, t3_.w); }
        yv0 = *(const u32x2*)yp; yv1 = *(const u32x2*)(yp + 256); yv2 = *(const u32x2*)(yp + 512); yv3 = *(const u32x2*)(yp + 768);
      }
    }
    float v[16];
    float sum = 0.f;
#pragma unroll
    for (int i = 0; i < 4; ++i) {
      const int c = lane * 4 + 256 * i;
      const f32x4 gt = GT[i];
      v[4 * i + 0] = ALPHA * ch[i].x + gt.x * bflo(cy[i].x); v[4 * i + 1] = ALPHA * ch[i].y + gt.y * bfhi(cy[i].x);
      v[4 * i + 2] = ALPHA * ch[i].z + gt.z * bflo(cy[i].y); v[4 * i + 3] = ALPHA * ch[i].w + gt.w * bfhi(cy[i].y);
      sum += v[4 * i] + v[4 * i + 1] + v[4 * i + 2] + v[4 * i + 3];
    }
    const float mean = wave_sum(sum) * (1.f / 1024.f);
    float sq = 0.f;
#pragma unroll
    for (int j = 0; j < 16; ++j) { v[j] -= mean; sq += v[j] * v[j]; }
    const float rstd = rsqrtf(wave_sum(sq) * (1.f / 1024.f) + LN_EPS);
#pragma unroll
    for (int i = 0; i < 4; ++i) {
      const int c = lane * 4 + 256 * i;
      const f32x4 g4 = LG[i], b4 = LB[i];
      float4 hn;
      hn.x = v[4 * i] * rstd * g4.x + b4.x; hn.y = v[4 * i + 1] * rstd * g4.y + b4.y;
      hn.z = v[4 * i + 2] * rstd * g4.z + b4.z; hn.w = v[4 * i + 3] * rstd * g4.w + b4.w;
      __builtin_nontemporal_store((f32x4){hn.x, hn.y, hn.z, hn.w}, (f32x4*)(hout + (size_t)row * D + c));
      const f32x4 sh = SH[i], sc4 = SC[i];
      v[4 * i] = hn.x * (1.f + sc4.x) + sh.x; v[4 * i + 1] = hn.y * (1.f + sc4.y) + sh.y;
      v[4 * i + 2] = hn.z * (1.f + sc4.z) + sh.z; v[4 * i + 3] = hn.w * (1.f + sc4.w) + sh.w;
      *(uint2*)(U + (size_t)row * D + c) = make_uint2(pack2(v[4 * i], v[4 * i + 1]), pack2(v[4 * i + 2], v[4 * i + 3]));
    }
    float a[16];
#pragma unroll
    for (int e = 0; e < 16; ++e) {
      float acc = 0.f;
#pragma unroll
      for (int i = 0; i < 4; ++i) {
        const float4 w4 = *(const float4*)(wrT + e * 1024 + lane * 4 + 256 * i);
        acc += v[4 * i] * w4.x + v[4 * i + 1] * w4.y + v[4 * i + 2] * w4.z + v[4 * i + 3] * w4.w;
      }
      a[e] = acc;
      if ((e & 3) == 3) asm volatile("" ::: "memory");
    }
    const bool b5 = (lane & 32) != 0, b4_ = (lane & 16) != 0, b3 = (lane & 8) != 0, b2 = (lane & 4) != 0;
    float r8[8], r4[4], r2[2];
#pragma unroll
    for (int i = 0; i < 8; ++i) { const float snd = b5 ? a[i] : a[i + 8]; const float kp = b5 ? a[i + 8] : a[i]; r8[i] = kp + __shfl_xor(snd, 32); }
#pragma unroll
    for (int i = 0; i < 4; ++i) { const float snd = b4_ ? r8[i] : r8[i + 4]; const float kp = b4_ ? r8[i + 4] : r8[i]; r4[i] = kp + __shfl_xor(snd, 16); }
#pragma unroll
    for (int i = 0; i < 2; ++i) { const float snd = b3 ? r4[i] : r4[i + 2]; const float kp = b3 ? r4[i + 2] : r4[i]; r2[i] = kp + __shfl_xor(snd, 8); }
    float lgt;
    { const float snd = b2 ? r2[0] : r2[1]; const float kp = b2 ? r2[1] : r2[0]; lgt = kp + __shfl_xor(snd, 4); }
    lgt += __shfl_xor(lgt, 2); lgt += __shfl_xor(lgt, 1);
    float mx = lgt;
    mx = fmaxf(mx, __shfl_xor(mx, 4)); mx = fmaxf(mx, __shfl_xor(mx, 8)); mx = fmaxf(mx, __shfl_xor(mx, 16)); mx = fmaxf(mx, __shfl_xor(mx, 32));
    const float ex = expf(lgt - mx);
    float se = ex;
    se += __shfl_xor(se, 4); se += __shfl_xor(se, 8); se += __shfl_xor(se, 16); se += __shfl_xor(se, 32);
    if ((lane & 3) == 0) aff[(size_t)(b * 16 + ((lane >> 2) & 15)) * S + t] = ex / se;
  }
}

DI void phase_topk(const Params& p, unsigned char* smem) {
  const int tid = threadIdx.x, lane = tid & 63, wave = tid >> 6;
  unsigned* hist = (unsigned*)smem;
  unsigned* wtot = hist + 256;
  const float* aff = (const float*)(p.ws + OFF_AFF);
  int* idx = (int*)(p.ws + OFF_IDX);
  float* gatev = (float*)(p.ws + OFF_GATEV);
  int* inv = (int*)(p.ws + OFF_INV);
  for (int be = blockIdx.x; be < NB_ * NE; be += gridDim.x) {
    const int b = be >> 4, e = be & 15;
    unsigned v[16];
#pragma unroll
    for (int i = 0; i < 4; ++i) {
      const float4 f = *(const float4*)(aff + (size_t)be * S + tid * 16 + i * 4);
      v[4 * i] = __float_as_uint(f.x); v[4 * i + 1] = __float_as_uint(f.y); v[4 * i + 2] = __float_as_uint(f.z); v[4 * i + 3] = __float_as_uint(f.w);
    }
    unsigned prefix = 0, mask = 0; int need = CAP;
#pragma unroll 1
    for (int pass = 0; pass < 4; ++pass) {
      const int shift = 24 - 8 * pass;
      __syncthreads();
      hist[tid] = 0;
      __syncthreads();
#pragma unroll
      for (int j = 0; j < 16; ++j) if ((v[j] & mask) == prefix) atomicAdd(&hist[(v[j] >> shift) & 255], 1u);
      __syncthreads();
      {
        const int hcount = (int)hist[tid];
        int sfx = hcount;
#pragma unroll
        for (int o = 1; o < 64; o <<= 1) { const int n = __shfl_down(sfx, o); if (lane + o < 64) sfx += n; }
        if (lane == 0) wtot[wave] = (unsigned)sfx;
        __syncthreads();
        for (int w = wave + 1; w < 4; ++w) sfx += (int)wtot[w];
        if (sfx >= need && sfx - hcount < need) { wtot[4] = (unsigned)tid; wtot[5] = (unsigned)(sfx - hcount); }
        __syncthreads();
        const int bin = (int)wtot[4];
        need -= (int)wtot[5];
        prefix |= (unsigned)bin << shift; mask |= 255u << shift;
      }
    }
    const unsigned T = prefix;
    int cg_ = 0, ce_ = 0;
#pragma unroll
    for (int j = 0; j < 16; ++j) { cg_ += (v[j] > T); ce_ += (v[j] == T); }
    int packed = cg_ | (ce_ << 16);
    int incl = packed;
#pragma unroll
    for (int o = 1; o < 64; o <<= 1) { const int n = __shfl_up(incl, o); if (lane >= o) incl += n; }
    __syncthreads();
    if (lane == 63) wtot[wave] = (unsigned)incl;
    __syncthreads();
    int base = incl - packed;
    for (int w = 0; w < wave; ++w) base += (int)wtot[w];
    int bg = base & 0xffff, beq = base >> 16;
    const int ngt = CAP - need;
#pragma unroll
    for (int j = 0; j < 16; ++j) {
      const int t = tid * 16 + j;
      int slot = -1;
      if (v[j] > T) { slot = bg; ++bg; }
      else if (v[j] == T) { if (beq < need) slot = ngt + beq; ++beq; }
      if (slot >= 0) { idx[be * CAP + slot] = t; gatev[be * CAP + slot] = __uint_as_float(v[j]); }
      inv[(size_t)(b * S + t) * NE + e] = slot;
    }
  }
}

DI void phase_moe_up(const Params& p, int l, unsigned char* smem) {
  const int lrow = threadIdx.x >> 2;
  const int* idx = (const int*)(p.ws + OFF_IDX);
  const bf16_t* U = (const bf16_t*)(p.ws + OFF_UA);
  bf16_t* act = (bf16_t*)(p.ws + OFF_ACT);
  XCD_LOOP(k, 256) {
    const int e = 4 * (k >> 6) + (x >> 1), m = k & 7, ct = (x & 1) * 8 + ((k >> 3) & 7);
    const int b = m >> 1, rt = m & 1, be = b * 16 + e;
    unsigned a_off[4];
#pragma unroll
    for (int i = 0; i < 4; ++i) a_off[i] = (unsigned)(b * S + idx[be * CAP + rt * 256 + lrow + 64 * i]) * D;
    const size_t wo = ((size_t)(l * 16 + e) * 1024 + ct * 64) * 1024;
    EpiStore ep; ep.dst = act + ((size_t)be * CAP + rt * 256) * FF + ct * 64; ep.ld = FF; ep.colscale = nullptr; ep.rowscale = nullptr; ep.cmode = 1;
    gemm_tile(U, a_off, (const bf16_t*)(p.ws + OFF_WT_G) + wo, (const bf16_t*)(p.ws + OFF_WT_U) + wo, D, D, smem, ep);
  }
}
DI void phase_moe_down(const Params& p, int l, unsigned char* smem) {
  const int lrow = threadIdx.x >> 2;
  const bf16_t* act = (const bf16_t*)(p.ws + OFF_ACT);
  bf16_t* Y2 = (bf16_t*)(p.ws + OFF_Y2);
  const float* gatev = (const float*)(p.ws + OFF_GATEV);
  XCD_LOOP(k, 128) {
    const int e = 8 * (k >> 6) + x, m = k & 7, ct = (k >> 3) & 7;
    const int b = m >> 1, rt = m & 1, be = b * 16 + e;
    unsigned a_off[4];
#pragma unroll
    for (int i = 0; i < 4; ++i) a_off[i] = (unsigned)(be * CAP + rt * 256 + lrow + 64 * i) * FF;
    const bf16_t* B = (const bf16_t*)(p.ws + OFF_WT_D) + ((size_t)(l * 16 + e) * 1024 + ct * 128) * 1024;
    EpiStore ep; ep.dst = Y2 + ((size_t)be * CAP + rt * 256) * D + ct * 128; ep.ld = D; ep.colscale = nullptr;
    ep.rowscale = gatev + be * CAP + rt * 256; ep.cmode = 0;
    gemm_tile(act, a_off, B, B + (size_t)64 * FF, FF, FF, smem, ep);
  }
}

DI void phase_ln_ffn(const Params& p, int l) {
  const int tid = threadIdx.x, lane = tid & 63, wave = tid >> 6;
  const float* hin = (const float*)(p.ws + OFF_H1);
  float* hout = p.out;
  const bf16_t* Y2 = (const bf16_t*)(p.ws + OFF_Y2);
  const int* inv = (const int*)(p.ws + OFF_INV);
  bf16_t* U = (bf16_t*)(p.ws + OFF_UB);
  const float* modv = (const float*)(p.ws + OFF_MOD);
  const float* lg = p.ln_ffn_g + l * D;
  const float* lb = p.ln_ffn_b + l * D;
  const int r0 = (int)(((long long)blockIdx.x * NTOK) / gridDim.x), r1 = (int)(((long long)(blockIdx.x + 1) * NTOK) / gridDim.x);
  const int stride = 4;
  int row = r0 + wave;
  f32x4 LG[4], LB[4], GT[4], SH[4], SC[4];
#pragma unroll
  for (int i = 0; i < 4; ++i) { LG[i] = *(const f32x4*)(lg + lane * 4 + 256 * i); LB[i] = *(const f32x4*)(lb + lane * 4 + 256 * i); SH[i] = LG[i]; SC[i] = LG[i]; }
  int cur_b = -1;
  float4 hv0, hv1, hv2, hv3; int nslot = -1;
  if (row < r1) {
    const float* hp = hin + (size_t)row * D + lane * 4;
    { const f32x4 t0_ = __builtin_nontemporal_load((const f32x4*)hp), t1_ = __builtin_nontemporal_load((const f32x4*)(hp + 256)), t2_ = __builtin_nontemporal_load((const f32x4*)(hp + 512)), t3_ = __builtin_nontemporal_load((const f32x4*)(hp + 768));
      hv0 = make_float4(t0_.x, t0_.y, t0_.z, t0_.w); hv1 = make_float4(t1_.x, t1_.y, t1_.z, t1_.w); hv2 = make_float4(t2_.x, t2_.y, t2_.z, t2_.w); hv3 = make_float4(t3_.x, t3_.y, t3_.z, t3_.w); }
    nslot = (lane < 16) ? inv[(size_t)row * NE + lane] : -1;
  }
  for (; row < r1; row += stride) {
    const int b = row >> 12;
    if (b != cur_b) {
      const float* mb = modv + (size_t)(l * 5 + b) * 6144 + lane * 4;
      const float* mn = modv + (size_t)(5 + b) * 6144 + lane * 4;
#pragma unroll
      for (int i = 0; i < 4; ++i) {
        GT[i] = *(const f32x4*)(mb + 5 * 1024 + 256 * i);
        if (l == 0) { SH[i] = *(const f32x4*)(mn + 256 * i); SC[i] = *(const f32x4*)(mn + 1024 + 256 * i); }
      }
      cur_b = b;
    }
    const float4 ch[4] = {hv0, hv1, hv2, hv3};
    const int myslot = nslot;
    {
      const int nrow = row + stride;
      if (nrow < r1) {
        const float* hp = hin + (size_t)nrow * D + lane * 4;
        { const f32x4 t0_ = __builtin_nontemporal_load((const f32x4*)hp), t1_ = __builtin_nontemporal_load((const f32x4*)(hp + 256)), t2_ = __builtin_nontemporal_load((const f32x4*)(hp + 512)), t3_ = __builtin_nontemporal_load((const f32x4*)(hp + 768));
      hv0 = make_float4(t0_.x, t0_.y, t0_.z, t0_.w); hv1 = make_float4(t1_.x, t1_.y, t1_.z, t1_.w); hv2 = make_float4(t2_.x, t2_.y, t2_.z, t2_.w); hv3 = make_float4(t3_.x, t3_.y, t3_.z, t3_.w); }
        nslot = (lane < 16) ? inv[(size_t)nrow * NE + lane] : -1;
      }
    }
    float f[16];
#pragma unroll
    for (int j = 0; j < 16; ++j) f[j] = 0.f;
    unsigned m = (unsigned)__ballot(myslot >= 0);
    const bf16_t* ybase = Y2 + (size_t)b * 16 * CAP * D + lane * 4;
    while (m) {
      int e0 = __ffs(m) - 1; m &= m - 1;
      int e1 = -1, e2 = -1, e3 = -1;
      if (m) { e1 = __ffs(m) - 1; m &= m - 1; }
      if (m) { e2 = __ffs(m) - 1; m &= m - 1; }
      if (m) { e3 = __ffs(m) - 1; m &= m - 1; }
      const int s0 = __shfl(myslot, e0), s1 = __shfl(myslot, e1 < 0 ? 0 : e1), s2 = __shfl(myslot, e2 < 0 ? 0 : e2), s3 = __shfl(myslot, e3 < 0 ? 0 : e3);
      u32x2 y0[4], y1[4], y2[4], y3[4];
#pragma unroll
      for (int i = 0; i < 4; ++i) { y1[i] = (u32x2){0u, 0u}; y2[i] = (u32x2){0u, 0u}; y3[i] = (u32x2){0u, 0u}; }
      {
        const bf16_t* yr = ybase + ((size_t)e0 * CAP + s0) * D;
#pragma unroll
        for (int i = 0; i < 4; ++i) y0[i] = *(const u32x2*)(yr + 256 * i);
      }
      if (e1 >= 0) { const bf16_t* yr = ybase + ((size_t)e1 * CAP + s1) * D;
#pragma unroll
        for (int i = 0; i < 4; ++i) y1[i] = *(const u32x2*)(yr + 256 * i); }
      if (e2 >= 0) { const bf16_t* yr = ybase + ((size_t)e2 * CAP + s2) * D;
#pragma unroll
        for (int i = 0; i < 4; ++i) y2[i] = *(const u32x2*)(yr + 256 * i); }
      if (e3 >= 0) { const bf16_t* yr = ybase + ((size_t)e3 * CAP + s3) * D;
#pragma unroll
        for (int i = 0; i < 4; ++i) y3[i] = *(const u32x2*)(yr + 256 * i); }
#pragma unroll
      for (int i = 0; i < 4; ++i) {
        f[4 * i] += (bflo(y0[i].x) + bflo(y1[i].x)) + (bflo(y2[i].x) + bflo(y3[i].x));
        f[4 * i + 1] += (bfhi(y0[i].x) + bfhi(y1[i].x)) + (bfhi(y2[i].x) + bfhi(y3[i].x));
        f[4 * i + 2] += (bflo(y0[i].y) + bflo(y1[i].y)) + (bflo(y2[i].y) + bflo(y3[i].y));
        f[4 * i + 3] += (bfhi(y0[i].y) + bfhi(y1[i].y)) + (bfhi(y2[i].y) + bfhi(y3[i].y));
      }
    }
    float v[16];
    float sum = 0.f;
#pragma unroll
    for (int i = 0; i < 4; ++i) {
      const int c = lane * 4 + 256 * i;
      const f32x4 gt = GT[i];
      v[4 * i + 0] = ALPHA * ch[i].x + gt.x * f[4 * i]; v[4 * i + 1] = ALPHA * ch[i].y + gt.y * f[4 * i + 1];
      v[4 * i + 2] = ALPHA * ch[i].z + gt.z * f[4 * i + 2]; v[4 * i + 3] = ALPHA * ch[i].w + gt.w * f[4 * i + 3];
      sum += v[4 * i] + v[4 * i + 1] + v[4 * i + 2] + v[4 * i + 3];
    }
    const float mean = wave_sum(sum) * (1.f / 1024.f);
    float sq = 0.f;
#pragma unroll
    for (int j = 0; j < 16; ++j) { v[j] -= mean; sq += v[j] * v[j]; }
    const float rstd = rsqrtf(wave_sum(sq) * (1.f / 1024.f) + LN_EPS);
#pragma unroll
    for (int i = 0; i < 4; ++i) {
      const int c = lane * 4 + 256 * i;
      const f32x4 g4 = LG[i], b4 = LB[i];
      float4 hn;
      hn.x = v[4 * i] * rstd * g4.x + b4.x; hn.y = v[4 * i + 1] * rstd * g4.y + b4.y;
      hn.z = v[4 * i + 2] * rstd * g4.z + b4.z; hn.w = v[4 * i + 3] * rstd * g4.w + b4.w;
      __builtin_nontemporal_store((f32x4){hn.x, hn.y, hn.z, hn.w}, (f32x4*)(hout + (size_t)row * D + c));
      if (l == 0) {
        const f32x4 sh = SH[i], sc4 = SC[i];
        *(uint2*)(U + (size_t)row * D + c) = make_uint2(pack2(hn.x * (1.f + sc4.x) + sh.x, hn.y * (1.f + sc4.y) + sh.y),
                                                        pack2(hn.z * (1.f + sc4.z) + sh.z, hn.w * (1.f + sc4.w) + sh.w));
      }
    }
  }
}

DI void phase_conv_in(const Params& p, unsigned char* smem) {
  const int lrow = threadIdx.x >> 2;
  const bf16_t* U = (const bf16_t*)(p.ws + OFF_UB);
  const bf16_t* Wt = (const bf16_t*)(p.ws + OFF_WT_CIN);
  XCD_LOOP(k, 192) {
    const int rt = 8 * x + k / 24, cc = k % 24;
    unsigned a_off[4];
#pragma unroll
    for (int i = 0; i < 4; ++i) a_off[i] = (unsigned)(rt * 256 + lrow + 64 * i) * D;
    EpiStore ep; ep.ld = D; ep.colscale = nullptr; ep.rowscale = nullptr;
    if (cc < 16) {
      ep.dst = (bf16_t*)(p.ws + OFF_CX) + (size_t)rt * 256 * D + cc * 64; ep.cmode = 2;
      gemm_tile(U, a_off, Wt + (size_t)(1024 + cc * 64) * D, Wt + (size_t)(2048 + cc * 64) * D, D, D, smem, ep);
    } else {
      const int ct = cc - 16;
      ep.dst = (bf16_t*)(p.ws + OFF_BG) + (size_t)rt * 256 * D + ct * 128; ep.cmode = 0;
      const bf16_t* B = Wt + (size_t)(ct * 128) * D;
      gemm_tile(U, a_off, B, B + (size_t)64 * D, D, D, smem, ep);
    }
  }
}
DI void phase_conv_gate(const Params& p) {
  const bf16_t* BG = (const bf16_t*)(p.ws + OFF_BG);
  const bf16_t* CX = (const bf16_t*)(p.ws + OFF_CX);
  bf16_t* Z = (bf16_t*)(p.ws + OFF_Z);
  const int total = NTOK * 128;
  for (int i = blockIdx.x * 256 + threadIdx.x; i < total; i += gridDim.x * 256) {
    const int row = i >> 7, c8 = (i & 127) * 8, t = row & 4095;
    float xm[8], x0[8], xp[8], bg[8], z[8];
    unpack8(*(const uint4*)(CX + (size_t)row * D + c8), x0);
    if (t > 0) unpack8(*(const uint4*)(CX + (size_t)(row - 1) * D + c8), xm);
    else {
#pragma unroll
      for (int j = 0; j < 8; ++j) xm[j] = 0.f; }
    if (t < S - 1) unpack8(*(const uint4*)(CX + (size_t)(row + 1) * D + c8), xp);
    else {
#pragma unroll
      for (int j = 0; j < 8; ++j) xp[j] = 0.f; }
    unpack8(*(const uint4*)(BG + (size_t)row * D + c8), bg);
#pragma unroll
    for (int j = 0; j < 8; ++j)
      z[j] = bg[j] * (p.conv_w[c8 + j] * xm[j] + p.conv_w[1024 + c8 + j] * x0[j] + p.conv_w[2048 + c8 + j] * xp[j]);
    *(uint4*)(Z + (size_t)row * D + c8) = pack8(z);
  }
}

#define XB_TMO      128
#define XB_XCNT(j)  (256  + 64 * (j))
#define XB_XSUB(j)  (1280 + 64 * (j))
#define XB_XGEN(j)  (2304 + 64 * (j))
#define XB_TOP      3328
#define XB_TOPGEN   3392
#define XCD_BAR_WORDS 3456
#define XB_SPIN_CAP (1u << 20)
DI unsigned xb_ld(unsigned* p) { return __hip_atomic_load(p, __ATOMIC_RELAXED, __HIP_MEMORY_SCOPE_AGENT); }
DI unsigned xb_add(unsigned* p, unsigned v) { return __hip_atomic_fetch_add(p, v, __ATOMIC_RELAXED, __HIP_MEMORY_SCOPE_AGENT); }
DI unsigned xb_xcc_id() { return (unsigned)__builtin_amdgcn_s_getreg((3 << 11) | 20) & 0xFu; }
#define XB_SPIN(cond, bar) do { unsigned _sp = 0; while (cond) { __builtin_amdgcn_s_sleep(1); \
    if ((++_sp & 255u) == 0u) { if (xb_ld(&(bar)[XB_TMO])) break; if (_sp > XB_SPIN_CAP) { atomicAdd(&(bar)[XB_TMO], 1u); break; } } } } while (0)
struct XcdBarrier { unsigned* bar; unsigned x; volatile unsigned* st; };
DI XcdBarrier xcd_barrier_post(unsigned* bar, volatile unsigned* st) {
  XcdBarrier b; b.bar = bar; b.x = xb_xcc_id(); b.st = st;
  if (threadIdx.x == 0) (void)xb_add(&bar[XB_XCNT(b.x)], 1u);
  return b;
}
DI void xcd_barrier_complete(unsigned* bar, unsigned x, unsigned& nloc, unsigned& nx) {
  const unsigned G = gridDim.x;
  unsigned sum, cnt, mine, sp = 0u;
  for (;;) {
    sum = 0u; cnt = 0u; mine = 0u;
#pragma unroll
    for (unsigned j = 0; j < 16; ++j) { const unsigned c = xb_ld(&bar[XB_XCNT(j)]); sum += c; cnt += (c > 0u) ? 1u : 0u; mine = (j == x) ? c : mine; }
    if (sum == G) break;
    __builtin_amdgcn_s_sleep(1);
    if ((++sp & 255u) == 0u) { if (xb_ld(&bar[XB_TMO])) break; if (sp > XB_SPIN_CAP) { atomicAdd(&bar[XB_TMO], 1u); break; } }
  }
  nloc = mine > 0u ? mine : 1u; nx = cnt > 0u ? cnt : 1u;
}
DI void xcd_barrier(const XcdBarrier& b) {
  asm volatile("s_waitcnt vmcnt(0)" ::: "memory");
  __syncthreads();
  if (threadIdx.x == 0) {
    unsigned* bar = b.bar;
    __builtin_amdgcn_s_waitcnt(0);
    unsigned nloc = b.st[0], nx = b.st[1];
    if (nloc == 0u) { xcd_barrier_complete(bar, b.x, nloc, nx); b.st[0] = nloc; b.st[1] = nx; }
    const unsigned old = xb_add(&bar[XB_XSUB(b.x)], 1u);
    const unsigned gen = old / nloc;
    if (old + 1u == (gen + 1u) * nloc) {
      __builtin_amdgcn_fence(__ATOMIC_RELEASE, "agent");
      asm volatile("s_waitcnt vmcnt(0)" ::: "memory");
      const unsigned og = xb_add(&bar[XB_TOP], 1u);
      const unsigned tg = og / nx;
      if (og + 1u == (tg + 1u) * nx) xb_add(&bar[XB_TOPGEN], 1u);
      else XB_SPIN(xb_ld(&bar[XB_TOPGEN]) == tg, bar);
      __builtin_amdgcn_fence(__ATOMIC_ACQUIRE, "agent");
      xb_add(&bar[XB_XGEN(b.x)], 1u);
      asm volatile("s_waitcnt vmcnt(0)" ::: "memory");
    } else {
      XB_SPIN(xb_ld(&bar[XB_XGEN(b.x)]) == gen, bar);
      __builtin_amdgcn_fence(__ATOMIC_ACQUIRE, "agent");
      asm volatile("s_waitcnt vmcnt(0)" ::: "memory");
    }
  }
  __syncthreads();
}

__global__ void __launch_bounds__(256, 2) fwd_megakernel(Params p) {
  extern __shared__ __attribute__((aligned(16))) unsigned char smem[];
  cg::grid_group grid = cg::this_grid();
  if (p.ph_lo < 0) grid.sync();
  volatile unsigned* xst = (volatile unsigned*)(smem + LDS_BYTES - 16);
  if (threadIdx.x == 0) { xst[0] = 0u; xst[1] = 0u; }
  __syncthreads();
  XcdBarrier xb = xcd_barrier_post((unsigned*)(p.ws + OFF_BAR), xst);
#ifndef DUPMASK
#define DUPMASK 0u
#endif
#define PH(n, call) if (p.ph_lo <= (n) && (n) < p.ph_hi) { call; if ((DUPMASK >> (n)) & 1u) { xcd_barrier(xb); call; } if ((n) + 1 < p.ph_hi) xcd_barrier(xb); }
  PH(0, phase_prologue(p, smem))
  PH(1, phase_mod_input(p))
  PH(2, phase_inproj(p, smem))
  PH(4, phase_attn_pool(p, smem))
  PH(5, phase_gemm_plain((const bf16_t*)(p.ws + OFF_CAT), (const bf16_t*)(p.ws + OFF_WT_OUT), (bf16_t*)(p.ws + OFF_Y), 8, D, smem))
  PH(6, phase_ln_mix(p, 0, smem))
  PH(7, phase_topk(p, smem))
  PH(8, phase_moe_up(p, 0, smem))
  PH(9, phase_moe_down(p, 0, smem))
  PH(10, phase_ln_ffn(p, 0))
  PH(11, phase_conv_in(p, smem))
  PH(12, phase_conv_gate(p))
  PH(13, phase_gemm_plain((const bf16_t*)(p.ws + OFF_Z), (const bf16_t*)(p.ws + OFF_WT_COUT), (bf16_t*)(p.ws + OFF_Y), 8, D, smem))
  PH(14, phase_ln_mix(p, 1, smem))
  PH(15, phase_topk(p, smem))
  PH(16, phase_moe_up(p, 1, smem))
  PH(17, phase_moe_down(p, 1, smem))
  PH(18, phase_ln_ffn(p, 1))
#undef PH
}

extern "C" void kernel_launch(void* const* d_in, const int* in_sizes, int n_in, void* d_out, int out_size, void* d_ws,
                              size_t ws_size, hipStream_t stream) {
  static int grid_blocks = 0;
  if (!grid_blocks) {
    if (n_in != 23 || ws_size < WS_END) { fprintf(stderr, "kernel_launch: unexpected n_in %d or ws_size %zu (need %zu)\n", n_in, ws_size, (size_t)WS_END); grid_blocks = -1; return; }
    int dev = 0, cus = 0, per_cu = 0;
    hipGetDevice(&dev);
    hipDeviceGetAttribute(&cus, hipDeviceAttributeMultiprocessorCount, dev);
    if (hipFuncSetAttribute((const void*)fwd_megakernel, hipFuncAttributeMaxDynamicSharedMemorySize, LDS_BYTES) != hipSuccess) { fprintf(stderr, "kernel_launch: hipFuncSetAttribute(%d B dynamic LDS) failed\n", LDS_BYTES); grid_blocks = -1; return; }
    hipOccupancyMaxActiveBlocksPerMultiprocessor(&per_cu, fwd_megakernel, 256, LDS_BYTES);
    if (per_cu < 1) per_cu = 1;
    if (per_cu > 2) per_cu = 2;
    grid_blocks = cus * per_cu;
  }
  if (grid_blocks < 0) return;
  Params p{};
  const float** f = (const float**)&p;
  for (int i = 0; i < 23; ++i) f[i] = (const float*)d_in[i];
  p.out = (float*)d_out; p.ws = (unsigned char*)d_ws; p.ph_lo = 0; p.ph_hi = 19;
  (void)hipMemsetAsync((unsigned char*)d_ws + OFF_BAR, 0, 16384, stream);
  void* args[] = {&p};
  hipError_t e = hipLaunchCooperativeKernel((void*)fwd_megakernel, dim3(grid_blocks), dim3(256), args, LDS_BYTES, stream);
  if (e != hipSuccess) fprintf(stderr, "cooperative launch failed: %s (grid %d)\n", hipGetErrorString(e), grid_blocks);
}
```

```cpp
#include <hip/hip_runtime.h>
#include <hip/hip_cooperative_groups.h>
#include <cstdio>
namespace cg = cooperative_groups;

typedef unsigned short bf16_t;
using bf16x8 = __attribute__((ext_vector_type(8))) short;
using f32x16 = __attribute__((ext_vector_type(16))) float;
typedef unsigned u32x4 __attribute__((ext_vector_type(4)));
typedef unsigned u32x2 __attribute__((ext_vector_type(2)));
typedef float f32x4 __attribute__((ext_vector_type(4)));
#define DI __device__ __forceinline__
#define MFMA32(a, b, c) __builtin_amdgcn_mfma_f32_32x32x16_bf16((a), (b), (c), 0, 0, 0)

constexpr int D = 1024, NB_ = 4, S = 4096, NTOK = NB_ * S, CTXL = 256, NCTX = NB_ * CTXL;
constexpr int NKEY = S + CTXL;
constexpr int NE = 16, CAP = 512, FF = 1024;
constexpr float LN_EPS = 1e-6f;
constexpr float QSCALE = 0.125f * 1.4426950408889634f;
constexpr float ALPHA = 1.41421356237309515f;

constexpr size_t MiB = 1ull << 20;
constexpr size_t OFF_WT_IN = 0;
constexpr size_t OFF_WT_OUT = OFF_WT_IN + 1280ull * 1024 * 2;
constexpr size_t OFF_WT_POOL = OFF_WT_OUT + 2 * MiB;
constexpr size_t OFF_WT_CIN = OFF_WT_POOL + 4ull * 128 * 128 * 2;
constexpr size_t OFF_WT_COUT = OFF_WT_CIN + 6 * MiB;
constexpr size_t OFF_WT_G = OFF_WT_COUT + 2 * MiB;
constexpr size_t OFF_WT_U = OFF_WT_G + 64 * MiB;
constexpr size_t OFF_WT_D = OFF_WT_U + 64 * MiB;
constexpr size_t OFF_MOD = OFF_WT_D + 64 * MiB;
constexpr size_t OFF_ROPE = OFF_MOD + 2ull * 5 * 6144 * 4;
constexpr size_t OFF_UCTX = OFF_ROPE + 8192;
constexpr size_t OFF_M = OFF_UCTX + 2 * MiB;
constexpr size_t OFF_Q = OFF_M;
constexpr size_t OFF_K = OFF_M + 16 * MiB;
constexpr size_t OFF_VT = OFF_M + 21 * MiB;
constexpr size_t OFF_P = OFF_M + 26 * MiB;
constexpr size_t OFF_POOLED = OFF_M + 42 * MiB;
constexpr size_t OFF_CAT = OFF_M + 58 * MiB;
constexpr size_t OFF_BG = OFF_M;
constexpr size_t OFF_CX = OFF_M + 32 * MiB;
constexpr size_t OFF_Z = OFF_M + 64 * MiB;
constexpr size_t OFF_ACT = OFF_M;
constexpr size_t OFF_UB = OFF_M + 96 * MiB;
constexpr size_t OFF_Y = OFF_M + 128 * MiB;
constexpr size_t OFF_UA = OFF_Y + 32 * MiB;
constexpr size_t OFF_Y2 = OFF_Y;
constexpr size_t OFF_H1 = OFF_UA + 32 * MiB;
constexpr size_t OFF_AFF = OFF_H1 + 64 * MiB;
constexpr size_t OFF_IDX = OFF_AFF + 1 * MiB;
constexpr size_t OFF_GATEV = OFF_IDX + 128 * 1024;
constexpr size_t OFF_INV = OFF_GATEV + 128 * 1024;
constexpr size_t OFF_BAR = OFF_INV + 1 * MiB;
constexpr size_t WS_END = OFF_BAR + 16384;

struct Params {
  const float *x, *c, *ctx, *c_ctx, *w_mod, *b_mod, *ln_mix_g, *ln_mix_b, *ln_ffn_g, *ln_ffn_b;
  const float *w_mix_in, *q_norm_g, *k_norm_g, *w_pool_grp, *pool_scale, *w_mix_out;
  const float *w_conv_in, *conv_w, *w_conv_out, *w_router, *w_exp_gate, *w_exp_up, *w_exp_down;
  float* out;
  unsigned char* ws;
  int ph_lo, ph_hi;
};

DI unsigned pack2(float a, float b) {
  typedef float f2 __attribute__((ext_vector_type(2)));
  typedef __bf16 b2 __attribute__((ext_vector_type(2)));
  f2 v = {a, b};
  b2 r = __builtin_convertvector(v, b2);
  return __builtin_bit_cast(unsigned, r);
}
DI float bflo(unsigned u) { return __uint_as_float(u << 16); }
DI float bfhi(unsigned u) { return __uint_as_float(u & 0xffff0000u); }
DI uint4 pack8(const float* v) { return make_uint4(pack2(v[0], v[1]), pack2(v[2], v[3]), pack2(v[4], v[5]), pack2(v[6], v[7])); }
DI void unpack8(uint4 u, float* v) {
  v[0] = bflo(u.x); v[1] = bfhi(u.x); v[2] = bflo(u.y); v[3] = bfhi(u.y);
  v[4] = bflo(u.z); v[5] = bfhi(u.z); v[6] = bflo(u.w); v[7] = bfhi(u.w);
}
DI int crow(int reg, int h) { return (reg & 3) + 8 * (reg >> 2) + 4 * h; }
DI float wave_sum(float v) {
#pragma unroll
  for (int o = 32; o >= 1; o >>= 1) v += __shfl_xor(v, o);
  return v;
}

constexpr int GST = 144;
constexpr int EST = 132;
constexpr int LDS_BYTES = 3 * 24576 + 16;

constexpr int GROW = 64;
constexpr int GSTG = 384 * GROW;
#define WAIT_VM(n) asm volatile("s_waitcnt vmcnt(" #n ")" ::: "memory")
#define GLDS16(g, l) __builtin_amdgcn_global_load_lds((const unsigned*)(g), (unsigned*)(l), 16, 0, 0)

template <class Epi>
DI void gemm_tile(const bf16_t* A, const unsigned (&a_off)[4], const bf16_t* B0, const bf16_t* B1, int ldb, int K,
                  unsigned char* smem, const Epi& epi) {
  const int tid = threadIdx.x, lane = tid & 63, wave = tid >> 6;
  const int wm = wave >> 1, wn = wave & 1;
  const int lrow = tid >> 2, kc = tid & 3;
  const int ql = lane & 31, h = lane >> 5;
  f32x16 acc[4][2];
#pragma unroll
  for (int mi = 0; mi < 4; ++mi)
#pragma unroll
    for (int ni = 0; ni < 2; ++ni)
#pragma unroll
      for (int r = 0; r < 16; ++r) acc[mi][ni][r] = 0.f;

  const int csrc = (kc ^ ((lrow >> 2) & 3)) * 8;
  const unsigned char* Ab = (const unsigned char*)A;
  const unsigned char* bp0 = (const unsigned char*)(B0 + (size_t)lrow * ldb + csrc);
  const unsigned char* bp1 = (const unsigned char*)(B1 + (size_t)lrow * ldb + csrc);
  unsigned ao[4];
#pragma unroll
  for (int i = 0; i < 4; ++i) ao[i] = (a_off[i] + csrc) * 2u;
  unsigned char* dbase = smem + wave * 1024;
  const int nk = K >> 5;
  WAIT_VM(0);
  __syncthreads();
  {
#pragma unroll
    for (int i = 0; i < 4; ++i) GLDS16(Ab + ao[i], dbase + i * 4096);
    GLDS16(bp0, dbase + 16384); GLDS16(bp1, dbase + 20480);
    const unsigned kb = (nk > 1) ? 64u : 0u;
#pragma unroll
    for (int i = 0; i < 4; ++i) GLDS16(Ab + ao[i] + kb, dbase + GSTG + i * 4096);
    GLDS16(bp0 + kb, dbase + GSTG + 16384); GLDS16(bp1 + kb, dbase + GSTG + 20480);
  }
  const int sw = (ql >> 2) & 3;
  const int o0 = ((0 + h) ^ sw) * 16, o1 = ((2 + h) ^ sw) * 16;
  const int aoffr = (wm * 128 + ql) * GROW;
  const int boffr = 256 * GROW + (wn * 64 + ql) * GROW;
  int cs = 0, ns = 2;
#pragma unroll 1
  for (int kt = 0; kt < nk; ++kt) {
    WAIT_VM(6);
    asm volatile("s_waitcnt lgkmcnt(0)" ::: "memory");
    __builtin_amdgcn_s_barrier();
    const unsigned char* cur = smem + cs * GSTG;
    unsigned char* nd = dbase + ns * GSTG;
    const unsigned kb = (unsigned)min(kt + 2, nk - 1) * 64u;
#pragma unroll
    for (int i = 0; i < 4; ++i) GLDS16(Ab + ao[i] + kb, nd + i * 4096);
    GLDS16(bp0 + kb, nd + 16384); GLDS16(bp1 + kb, nd + 20480);
    bf16x8 af0[4], bf0[2], af1[4], bf1[2];
#pragma unroll
    for (int mi = 0; mi < 4; ++mi) af0[mi] = *(const bf16x8*)(cur + aoffr + mi * 32 * GROW + o0);
#pragma unroll
    for (int ni = 0; ni < 2; ++ni) bf0[ni] = *(const bf16x8*)(cur + boffr + ni * 32 * GROW + o0);
#pragma unroll
    for (int mi = 0; mi < 4; ++mi) af1[mi] = *(const bf16x8*)(cur + aoffr + mi * 32 * GROW + o1);
#pragma unroll
    for (int ni = 0; ni < 2; ++ni) bf1[ni] = *(const bf16x8*)(cur + boffr + ni * 32 * GROW + o1);
#pragma unroll
    for (int mi = 0; mi < 4; ++mi)
#pragma unroll
      for (int ni = 0; ni < 2; ++ni) acc[mi][ni] = MFMA32(af0[mi], bf0[ni], acc[mi][ni]);
#pragma unroll
    for (int mi = 0; mi < 4; ++mi)
#pragma unroll
      for (int ni = 0; ni < 2; ++ni) acc[mi][ni] = MFMA32(af1[mi], bf1[ni], acc[mi][ni]);
    __builtin_amdgcn_sched_group_barrier(0x100, 6, 0);
#pragma unroll
    for (int i = 0; i < 6; ++i) {
      __builtin_amdgcn_sched_group_barrier(0x008, 1, 0);
      __builtin_amdgcn_sched_group_barrier(0x100, 1, 0);
    }
    __builtin_amdgcn_sched_group_barrier(0x008, 10, 0);
    cs = (cs == 2) ? 0 : cs + 1;
    ns = (ns == 2) ? 0 : ns + 1;
  }
  WAIT_VM(0);
  __syncthreads();
  float* st = (float*)smem;
  int tl = tid;
  asm volatile("" : "+v"(tl));
#pragma unroll
  for (int q = 0; q < 4; ++q) {
    if (wm == (q >> 1)) {
#pragma unroll
      for (int m2 = 0; m2 < 2; ++m2)
#pragma unroll
        for (int ni = 0; ni < 2; ++ni)
#pragma unroll
          for (int r = 0; r < 16; ++r)
            st[(m2 * 32 + crow(r, h)) * EST + wn * 64 + ni * 32 + ql] = acc[(q & 1) * 2 + m2][ni][r];
    }
    __syncthreads();
    epi.process(st, q, tl);
    __syncthreads();
  }
}

struct EpiStore {
  bf16_t* dst;
  int ld;
  const float* colscale;
  const float* rowscale;
  int cmode;
  DI void process(const float* st, int hm, int tid) const {
    if (cmode != 0) {
#pragma unroll
      for (int i = 0; i < 2; ++i) {
        const int c = tid + 256 * i, r = c >> 3, cc = c & 7;
        const float4 a0 = *(const float4*)(st + r * EST + cc * 8), a1 = *(const float4*)(st + r * EST + cc * 8 + 4);
        const float4 b0 = *(const float4*)(st + r * EST + 64 + cc * 8), b1 = *(const float4*)(st + r * EST + 64 + cc * 8 + 4);
        float a[8] = {a0.x, a0.y, a0.z, a0.w, a1.x, a1.y, a1.z, a1.w};
        const float b[8] = {b0.x, b0.y, b0.z, b0.w, b1.x, b1.y, b1.z, b1.w};
        if (cmode == 1) {
#pragma unroll
          for (int j = 0; j < 8; ++j) a[j] = a[j] / (1.f + __expf(-a[j])) * b[j];
        } else {
#pragma unroll
          for (int j = 0; j < 8; ++j) a[j] = a[j] * b[j];
        }
        *(uint4*)(dst + (size_t)(hm * 64 + r) * ld + cc * 8) = pack8(a);
      }
      return;
    }
#pragma unroll
    for (int i = 0; i < 4; ++i) {
      const int c = tid + 256 * i, r = c >> 4, cc = c & 15;
      const float4 a = *(const float4*)(st + r * EST + cc * 8);
      const float4 b = *(const float4*)(st + r * EST + cc * 8 + 4);
      float v[8] = {a.x, a.y, a.z, a.w, b.x, b.y, b.z, b.w};
      const int row = hm * 64 + r;
      if (rowscale) { const float rs = rowscale[row];
#pragma unroll
        for (int j = 0; j < 8; ++j) v[j] *= rs; }
      if (colscale) {
#pragma unroll
        for (int j = 0; j < 8; ++j) v[j] *= colscale[cc * 8 + j]; }
      *(uint4*)(dst + (size_t)row * ld + cc * 8) = pack8(v);
    }
  }
};

struct EpiInProj {
  unsigned char* ws;
  const float *qg, *kg;
  int row0;
  int is_ctx;
  int ct;
  DI void process(const float* st, int hm, int tid) const {
    if (ct == 5) {
      bf16_t* Vt = (bf16_t*)(ws + OFF_VT);
#pragma unroll
      for (int i = 0; i < 4; ++i) {
        const int c = tid + 256 * i, d = c >> 3, rc = c & 7;
        float v[8];
#pragma unroll
        for (int j = 0; j < 8; ++j) v[j] = st[(rc * 8 + j) * EST + d];
        const int r = row0 + hm * 64 + rc * 8;
        const int b = is_ctx ? (r >> 8) : (r >> 12);
        const int key = is_ctx ? (r & 255) : (CTXL + (r & 4095));
        *(uint4*)(Vt + ((size_t)((b * 2 + (d >> 6)) * 64 + (d & 63))) * NKEY + key) = pack8(v);
      }
      return;
    }
    const float* cos_t = (const float*)(ws + OFF_ROPE);
    const float* sin_t = cos_t + 1024;
#pragma unroll
    for (int i = 0; i < 4; ++i) {
      const int c = tid + 256 * i, r = c >> 4, cc = c & 15;
      const float4 a = *(const float4*)(st + r * EST + cc * 8);
      const float4 bb = *(const float4*)(st + r * EST + cc * 8 + 4);
      float v[8] = {a.x, a.y, a.z, a.w, bb.x, bb.y, bb.z, bb.w};
      const int grow = row0 + hm * 64 + r;
      if (ct <= 4) {
        float ss = 0.f;
#pragma unroll
        for (int j = 0; j < 8; ++j) ss += v[j] * v[j];
        ss += __shfl_xor(ss, 1); ss += __shfl_xor(ss, 2); ss += __shfl_xor(ss, 4);
        const float rinv = rsqrtf(ss * (1.f / 64.f) + LN_EPS);
        const float* g = (ct < 4 ? qg : kg) + (cc & 7) * 8;
#pragma unroll
        for (int j = 0; j < 8; ++j) v[j] = v[j] * rinv * g[j];
        if (!is_ctx) {
          const int t = grow & 4095, rowp = t >> 6, colp = t & 63;
#pragma unroll
          for (int jj = 0; jj < 4; ++jj) {
            const int pidx = (cc & 7) * 4 + jj;
            const int pos = (pidx < 16) ? rowp : colp;
            const float cs = cos_t[pos * 16 + (pidx & 15)], sn = sin_t[pos * 16 + (pidx & 15)];
            const float x0 = v[2 * jj], x1 = v[2 * jj + 1];
            v[2 * jj] = x0 * cs - x1 * sn;
            v[2 * jj + 1] = x0 * sn + x1 * cs;
          }
        }
        if (ct < 4) {
#pragma unroll
          for (int j = 0; j < 8; ++j) v[j] *= QSCALE;
          *(uint4*)((bf16_t*)(ws + OFF_Q) + (size_t)grow * 512 + ct * 128 + cc * 8) = pack8(v);
        } else {
          const int b = is_ctx ? (grow >> 8) : (grow >> 12);
          const int key = is_ctx ? (grow & 255) : (CTXL + (grow & 4095));
          *(uint4*)((bf16_t*)(ws + OFF_K) + ((size_t)(b * 2 + (cc >> 3)) * NKEY + key) * 64 + (cc & 7) * 8) = pack8(v);
        }
      } else {
        *(uint4*)((bf16_t*)(ws + OFF_P) + (size_t)grow * 512 + (ct - 6) * 128 + cc * 8) = pack8(v);
      }
    }
  }
};

DI void cvt_tile(const float* __restrict__ src, bf16_t* dst, int K, int N, int kt, int nt, float* st) {
  const int tid = threadIdx.x;
  const int k0 = kt * 64, n0 = nt * 64;
  __syncthreads();
#pragma unroll
  for (int i = 0; i < 4; ++i) {
    const int k = (tid >> 4) + 16 * i, n4 = (tid & 15) * 4;
    const f32x4 v = __builtin_nontemporal_load((const f32x4*)(src + (size_t)(k0 + k) * N + n0 + n4));
    st[k * 65 + n4 + 0] = v.x; st[k * 65 + n4 + 1] = v.y; st[k * 65 + n4 + 2] = v.z; st[k * 65 + n4 + 3] = v.w;
  }
  __syncthreads();
#pragma unroll
  for (int i = 0; i < 2; ++i) {
    const int c = tid + 256 * i, n = c >> 3, kc = c & 7;
    float v[8];
#pragma unroll
    for (int j = 0; j < 8; ++j) v[j] = st[(kc * 8 + j) * 65 + n];
    *(uint4*)(dst + (size_t)(n0 + n) * K + k0 + kc * 8) = pack8(v);
  }
}

DI void modgemv_item(const Params& p, int item, float* sm) {
  const int tid = threadIdx.x, lane = tid & 63, wave = tid >> 6;
  const int l = item / 96, n0 = (item % 96) * 64;
  float* red = sm + 5120;
  __syncthreads();
  for (int i = tid; i < 5120; i += 256) {
    const int r = i >> 10, k = i & 1023;
    const float cv = (r < 4) ? p.c[r * 1024 + k] : p.c_ctx[k];
    sm[i] = cv / (1.f + expf(-cv));
  }
  __syncthreads();
  const int sub = lane >> 4, c4 = (lane & 15) * 4;
  f32x4 a0 = {0.f, 0.f, 0.f, 0.f}, a1 = a0, a2 = a0, a3 = a0, a4 = a0;
  const float* w = p.w_mod + (size_t)l * 1024 * 6144 + n0 + c4;
  const int kb = wave * 256 + sub;
#pragma unroll 8
  for (int kk = 0; kk < 64; ++kk) {
    const int k = kb + kk * 4;
    const f32x4 wv = __builtin_nontemporal_load((const f32x4*)(w + (size_t)k * 6144));
    a0 += sm[k] * wv; a1 += sm[1024 + k] * wv; a2 += sm[2048 + k] * wv; a3 += sm[3072 + k] * wv; a4 += sm[4096 + k] * wv;
  }
#pragma unroll
  for (int j = 0; j < 4; ++j) {
    a0[j] += __shfl_xor(a0[j], 16); a0[j] += __shfl_xor(a0[j], 32);
    a1[j] += __shfl_xor(a1[j], 16); a1[j] += __shfl_xor(a1[j], 32);
    a2[j] += __shfl_xor(a2[j], 16); a2[j] += __shfl_xor(a2[j], 32);
    a3[j] += __shfl_xor(a3[j], 16); a3[j] += __shfl_xor(a3[j], 32);
    a4[j] += __shfl_xor(a4[j], 16); a4[j] += __shfl_xor(a4[j], 32);
  }
  if (sub == 0) {
    *(f32x4*)(red + (wave * 5 + 0) * 64 + c4) = a0; *(f32x4*)(red + (wave * 5 + 1) * 64 + c4) = a1; *(f32x4*)(red + (wave * 5 + 2) * 64 + c4) = a2;
    *(f32x4*)(red + (wave * 5 + 3) * 64 + c4) = a3; *(f32x4*)(red + (wave * 5 + 4) * 64 + c4) = a4;
  }
  __syncthreads();
  float* modv = (float*)(p.ws + OFF_MOD);
  for (int o = tid; o < 320; o += 256) {
    const int r = o >> 6, ln = o & 63;
    float s = p.b_mod[l * 6144 + n0 + ln];
#pragma unroll
    for (int w4 = 0; w4 < 4; ++w4) s += red[(w4 * 5 + r) * 64 + ln];
    modv[(size_t)(l * 5 + r) * 6144 + n0 + ln] = s;
  }
}

DI void phase_prologue(const Params& p, unsigned char* smem) {
  constexpr int N_GEMV = 192, N_ROPE = 1;
  constexpr int T_IN = 16 * 20, T_POOL = 16, T_OUT = 256, T_CIN = 16 * 48, T_COUT = 256, T_EXP = 8192;
  constexpr int total = N_GEMV + N_ROPE + T_IN + T_POOL + T_OUT;
  float* sm = (float*)smem;
  for (int it = blockIdx.x; it < total; it += gridDim.x) {
    int t = it;
    if (t < N_GEMV) { modgemv_item(p, t, sm); continue; }
    t -= N_GEMV;
    if (t < N_ROPE) {
      float* cos_t = (float*)(p.ws + OFF_ROPE);
      for (int i = threadIdx.x; i < 1024; i += 256) {
        const int pos = i >> 4, fi = i & 15;
        const float inv = exp2f(-(float)fi * (13.287712379549449f / 16.f));
        const float ang = (float)pos * inv;
        cos_t[i] = cosf(ang); cos_t[1024 + i] = sinf(ang);
      }
      continue;
    }
    t -= N_ROPE;
    if (t < T_IN) { cvt_tile(p.w_mix_in, (bf16_t*)(p.ws + OFF_WT_IN), 1024, 1280, t / 20, t % 20, sm); continue; }
    t -= T_IN;
    if (t < T_POOL) { const int g = t >> 2, r = t & 3;
      cvt_tile(p.w_pool_grp + g * 16384, (bf16_t*)(p.ws + OFF_WT_POOL) + g * 16384, 128, 128, r >> 1, r & 1, sm); continue; }
    t -= T_POOL;
    cvt_tile(p.w_mix_out, (bf16_t*)(p.ws + OFF_WT_OUT), 1024, 1024, t >> 4, t & 15, sm);
  }
}

constexpr int N_LATE = 768 + 256 + 3 * 8192;
DI void cvt_late_tile(const Params& p, int t, float* sm) {
  if (t < 768) { cvt_tile(p.w_conv_in, (bf16_t*)(p.ws + OFF_WT_CIN), 1024, 3072, t / 48, t % 48, sm); return; }
  t -= 768;
  if (t < 256) { cvt_tile(p.w_conv_out, (bf16_t*)(p.ws + OFF_WT_COUT), 1024, 1024, t >> 4, t & 15, sm); return; }
  t -= 256;
  const int which = t >> 13, r = t & 8191, mat = r >> 8, tt = r & 255;
  const float* src = (which == 0 ? p.w_exp_gate : which == 1 ? p.w_exp_up : p.w_exp_down) + (size_t)mat * 1048576;
  bf16_t* dst = (bf16_t*)(p.ws + (which == 0 ? OFF_WT_G : which == 1 ? OFF_WT_U : OFF_WT_D)) + (size_t)mat * 1048576;
  cvt_tile(src, dst, 1024, 1024, tt >> 4, tt & 15, sm);
}
struct CvtDesc { const float* src; bf16_t* dst; int K, N, k0, n0; };
DI CvtDesc cvt_late_desc(const Params& p, int t) {
  CvtDesc d;
  if (t < 768) { d.src = p.w_conv_in; d.dst = (bf16_t*)(p.ws + OFF_WT_CIN); d.K = 1024; d.N = 3072; d.k0 = (t / 48) * 64; d.n0 = (t % 48) * 64; return d; }
  t -= 768;
  if (t < 256) { d.src = p.w_conv_out; d.dst = (bf16_t*)(p.ws + OFF_WT_COUT); d.K = 1024; d.N = 1024; d.k0 = (t >> 4) * 64; d.n0 = (t & 15) * 64; return d; }
  t -= 256;
  const int which = t >> 13, r = t & 8191, mat = r >> 8, tt = r & 255;
  d.src = (which == 0 ? p.w_exp_gate : which == 1 ? p.w_exp_up : p.w_exp_down) + (size_t)mat * 1048576;
  d.dst = (bf16_t*)(p.ws + (which == 0 ? OFF_WT_G : which == 1 ? OFF_WT_U : OFF_WT_D)) + (size_t)mat * 1048576;
  d.K = 1024; d.N = 1024; d.k0 = (tt >> 4) * 64; d.n0 = (tt & 15) * 64;
  return d;
}
DI int late_n_idle() { return 0; }
DI int late_n_early() { return min(14 * late_n_idle(), N_LATE); }
DI void cvt_late_range(const Params& p, int i0, int i1, float* sm) {
  const int base = late_n_early();
  for (int i = i0; i < i1; ++i) { const int t = base + blockIdx.x + i * gridDim.x; if (t < N_LATE) cvt_late_tile(p, t, sm); }
}

DI void phase_mod_input(const Params& p) {
  const float* modv = (const float*)(p.ws + OFF_MOD);
  bf16_t* uA = (bf16_t*)(p.ws + OFF_UA);
  bf16_t* uC = (bf16_t*)(p.ws + OFF_UCTX);
  const int total = (NTOK + NCTX) * 128;
  for (int i = blockIdx.x * 256 + threadIdx.x; i < total; i += gridDim.x * 256) {
    const int row = i >> 7, c8 = (i & 127) * 8;
    const float* src; bf16_t* dst; int mr;
    if (row < NTOK) { src = p.x + (size_t)row * D + c8; dst = uA + (size_t)row * D + c8; mr = row >> 12; }
    else { const int r = row - NTOK; src = p.ctx + (size_t)r * D + c8; dst = uC + (size_t)r * D + c8; mr = 4; }
    const float* sh = modv + (size_t)mr * 6144 + c8;
    const float* sc = sh + 1024;
    const float4 a = *(const float4*)src, b = *(const float4*)(src + 4);
    const float4 s0 = *(const float4*)sh, s1 = *(const float4*)(sh + 4);
    const float4 c0 = *(const float4*)sc, c1 = *(const float4*)(sc + 4);
    float v[8] = {a.x * (1.f + c0.x) + s0.x, a.y * (1.f + c0.y) + s0.y, a.z * (1.f + c0.z) + s0.z, a.w * (1.f + c0.w) + s0.w,
                  b.x * (1.f + c1.x) + s1.x, b.y * (1.f + c1.y) + s1.y, b.z * (1.f + c1.z) + s1.z, b.w * (1.f + c1.w) + s1.w};
    *(uint4*)dst = pack8(v);
  }
}

#define XCD_LOOP(k, n_x) const int x = blockIdx.x & 7, nper_ = gridDim.x >> 3; for (int k = blockIdx.x >> 3; k < (n_x); k += nper_)

DI void phase_inproj(const Params& p, unsigned char* smem) {
  const bf16_t* Wt = (const bf16_t*)(p.ws + OFF_WT_IN);
  const int lrow = threadIdx.x >> 2;
  XCD_LOOP(k, 81) {
    EpiInProj e; e.ws = p.ws; e.qg = p.q_norm_g; e.kg = p.k_norm_g;
    const bf16_t* A; int rt, ct;
    if (k < 80) { rt = 8 * x + k / 10; ct = k % 10; A = (const bf16_t*)(p.ws + OFF_UA); e.is_ctx = 0; }
    else { rt = x >> 1; ct = 4 + (x & 1); A = (const bf16_t*)(p.ws + OFF_UCTX); e.is_ctx = 1; }
    e.row0 = rt * 256; e.ct = ct;
    unsigned a_off[4];
#pragma unroll
    for (int i = 0; i < 4; ++i) a_off[i] = (unsigned)(rt * 256 + lrow + 64 * i) * D;
    const bf16_t* B = Wt + (size_t)ct * 128 * D;
    gemm_tile(A, a_off, B, B + (size_t)64 * D, D, D, smem, e);
  }
  {
    const int nper = gridDim.x >> 3, j = blockIdx.x >> 3, n_idle = late_n_idle();
    if (n_idle > 0 && j >= 17) {
      const int rank = (blockIdx.x & 7) * (nper - 17) + (j - 17), n_early = late_n_early();
      for (int t = rank; t < n_early; t += n_idle) cvt_late_tile(p, t, (float*)smem);
    }
  }
}

template <int HW>
DI void pooled_one(const bf16_t* __restrict__ P, bf16_t* __restrict__ PO, int row, int c8) {
  const int t = row & 4095, base = row - t;
  u32x4 v[2 * HW];
#pragma unroll
  for (int k = 0; k < 2 * HW; ++k) {
    const int sc = min(max(t - HW + k, 0), S - 1);
    v[k] = *(const u32x4*)(P + (size_t)(base + sc) * 512 + c8);
  }
  float acc[8] = {0.f, 0.f, 0.f, 0.f, 0.f, 0.f, 0.f, 0.f};
#pragma unroll
  for (int k = 0; k < 2 * HW; ++k) {
    const int sr = t - HW + k;
    const float w = (sr >= 0 && sr < S) ? 1.f : 0.f;
    acc[0] += w * bflo(v[k].x); acc[1] += w * bfhi(v[k].x); acc[2] += w * bflo(v[k].y); acc[3] += w * bfhi(v[k].y);
    acc[4] += w * bflo(v[k].z); acc[5] += w * bfhi(v[k].z); acc[6] += w * bflo(v[k].w); acc[7] += w * bfhi(v[k].w);
  }
  const float rc = 1.f / (float)(min(t + HW, S) - max(t - HW, 0));
  const u32x4 sv = v[HW];
  float o[8] = {acc[0] * rc - bflo(sv.x), acc[1] * rc - bfhi(sv.x), acc[2] * rc - bflo(sv.y), acc[3] * rc - bfhi(sv.y),
                acc[4] * rc - bflo(sv.z), acc[5] * rc - bfhi(sv.z), acc[6] * rc - bflo(sv.w), acc[7] * rc - bfhi(sv.w)};
  *(uint4*)(PO + (size_t)row * 512 + c8) = pack8(o);
}
DI void phase_pooled(const Params& p) {
  const bf16_t* P = (const bf16_t*)(p.ws + OFF_P);
  bf16_t* PO = (bf16_t*)(p.ws + OFF_POOLED);
  const int total = NTOK * 64;
  for (int i = blockIdx.x * 256 + threadIdx.x; i < total; i += gridDim.x * 256) {
    const int lane = i & 63, wq = i >> 6, g = wq & 3, row = (wq >> 2) * 4 + (lane >> 4), c8 = g * 128 + (lane & 15) * 8;
    if (g == 0) pooled_one<1>(P, PO, row, c8);
    else if (g == 1) pooled_one<2>(P, PO, row, c8);
    else if (g == 2) pooled_one<4>(P, PO, row, c8);
    else pooled_one<8>(P, PO, row, c8);
  }
}

constexpr int AK_ST = 144, AV_ST = 136;
constexpr int ABUF = 64 * AK_ST + 64 * AV_ST;

constexpr int CVT_R0 = 36864, CVT_RSZ = 16384;
DI int late_tile_of(int i) { const int t = late_n_early() + (int)blockIdx.x + i * (int)gridDim.x; return (t < N_LATE) ? t : -1; }
DI void cvt_dma_issue(const Params& p, int t, unsigned char* reg, int tid) {
  const CvtDesc d = cvt_late_desc(p, t);
  const int lane = tid & 63, wave = tid >> 6;
#pragma unroll
  for (int i = 0; i < 4; ++i) {
    const int k = (i * 4 + wave) * 4 + (lane >> 4), pos = lane & 15;
    const float* g = d.src + (size_t)(d.k0 + k) * d.N + d.n0 + ((pos ^ ((k >> 3) & 7)) << 2);
    __builtin_amdgcn_global_load_lds((const unsigned*)g, (unsigned*)(reg + (i * 4 + wave) * 1024), 16, 0, 2);
  }
}
DI void cvt_lds_store(const Params& p, int t, const unsigned char* reg, int tid) {
  const CvtDesc d = cvt_late_desc(p, t);
  const float* R = (const float*)reg;
#pragma unroll
  for (int i = 0; i < 2; ++i) {
    const int c = tid + 256 * i, n = c >> 3, kc = c & 7;
    float v[8];
#pragma unroll
    for (int jj = 0; jj < 8; ++jj) v[jj] = R[(kc * 8 + jj) * 64 + ((((n >> 2) ^ kc) & 15) << 2) + (n & 3)];
    const uint4 o4 = pack8(v);
    __builtin_nontemporal_store((u32x4){o4.x, o4.y, o4.z, o4.w}, (u32x4*)(d.dst + (size_t)(d.n0 + n) * d.K + d.k0 + kc * 8));
  }
}

DI void attn_item(const Params& p, int item, unsigned char* smem, int cvt_i0, int cvt_n) {
  int tid_ = threadIdx.x;
  asm volatile("" : "+v"(tid_));
  const int tid = tid_, lane = tid & 63, wave = tid >> 6, ql = lane & 31, h = lane >> 5;
  const int qb = item & 15, head = (item >> 4) & 7, b = item >> 7, kvh = head >> 2;
  const int tok0 = b * S + qb * 256 + wave * 64 + ql;
  bf16x8 qf[2][4];
#pragma unroll
  for (int g = 0; g < 2; ++g) {
    const bf16_t* Qp = (const bf16_t*)(p.ws + OFF_Q) + (size_t)(tok0 + g * 32) * 512 + head * 64;
#pragma unroll
    for (int s = 0; s < 4; ++s) qf[g][s] = *(const bf16x8*)(Qp + s * 16 + h * 8);
  }
  const bf16_t* Kg = (const bf16_t*)(p.ws + OFF_K) + (size_t)(b * 2 + kvh) * NKEY * 64;
  const bf16_t* Vg = (const bf16_t*)(p.ws + OFF_VT) + (size_t)(b * 2 + kvh) * 64 * NKEY;
  const int lr = tid >> 3, kc = tid & 7;
  const bf16_t* kp = Kg + (size_t)lr * 64 + kc * 8;
  const bf16_t* vp = Vg + (size_t)lr * NKEY + kc * 8;
  u32x4 rk0 = *(const u32x4*)kp, rk1 = *(const u32x4*)(kp + 32 * 64);
  u32x4 rv0 = *(const u32x4*)vp, rv1 = *(const u32x4*)(vp + (size_t)32 * NKEY);
  const int wko = lr * AK_ST + kc * 16, wvo = 64 * AK_ST + lr * AV_ST + kc * 16;
  __syncthreads();
  {
    unsigned char* wk = smem + wko; unsigned char* wv = smem + wvo;
    *(u32x4*)wk = rk0; *(u32x4*)(wk + 32 * AK_ST) = rk1;
    *(u32x2*)wv = rv0.xy; *(u32x2*)(wv + 8) = rv0.zw; *(u32x2*)(wv + 32 * AV_ST) = rv1.xy; *(u32x2*)(wv + 32 * AV_ST + 8) = rv1.zw;
  }
  __syncthreads();
  f32x16 o[2][2];
#pragma unroll
  for (int r = 0; r < 16; ++r) { o[0][0][r] = 0.f; o[0][1][r] = 0.f; o[1][0][r] = 0.f; o[1][1][r] = 0.f; }
  float m_old[2] = {-1e30f, -1e30f}, lsum[2] = {0.f, 0.f};
  constexpr int NT = NKEY / 64;
  for (int j = 0; j < NT; ++j) {
    const unsigned char* sK = smem + (j & 1) * ABUF;
    const unsigned char* sV = sK + 64 * AK_ST;
    int tid2 = tid;
    asm volatile("" : "+v"(tid2));
    if (j < cvt_n) { const int t = late_tile_of(cvt_i0 + j); if (t >= 0) cvt_dma_issue(p, t, smem + CVT_R0 + (j & 1) * CVT_RSZ, tid2); }
    if (j >= 1 && j <= cvt_n) { const int t = late_tile_of(cvt_i0 + j - 1); if (t >= 0) cvt_lds_store(p, t, smem + CVT_R0 + ((j - 1) & 1) * CVT_RSZ, tid2); }
    __builtin_amdgcn_sched_barrier(0);
    if (j + 1 < NT) {
      const int key0 = (j + 1) * 64;
      rk0 = *(const u32x4*)(kp + (size_t)key0 * 64); rk1 = *(const u32x4*)(kp + (size_t)(key0 + 32) * 64);
      rv0 = *(const u32x4*)(vp + key0); rv1 = *(const u32x4*)(vp + (size_t)32 * NKEY + key0);
    }
    f32x16 st[2][2];
#pragma unroll
    for (int g = 0; g < 2; ++g)
#pragma unroll
      for (int kt = 0; kt < 2; ++kt)
#pragma unroll
        for (int r = 0; r < 16; ++r) st[g][kt][r] = 0.f;
#pragma unroll
    for (int kt = 0; kt < 2; ++kt)
#pragma unroll
      for (int s = 0; s < 4; ++s) {
        const bf16x8 kf = *(const bf16x8*)(sK + (kt * 32 + ql) * AK_ST + s * 32 + h * 16);
        st[0][kt] = MFMA32(kf, qf[0][s], st[0][kt]);
        st[1][kt] = MFMA32(kf, qf[1][s], st[1][kt]);
      }
#pragma unroll
    for (int g = 0; g < 2; ++g) {
      float mx = st[g][0][0];
#pragma unroll
      for (int r = 0; r < 16; ++r) { mx = fmaxf(mx, st[g][0][r]); mx = fmaxf(mx, st[g][1][r]); }
      mx = fmaxf(mx, __shfl_xor(mx, 32));
      const float m_new = fmaxf(m_old[g], mx);
      if (__any(m_new > m_old[g])) {
        const float alpha = __builtin_amdgcn_exp2f(m_old[g] - m_new);
        m_old[g] = m_new;
        o[g][0] = o[g][0] * alpha; o[g][1] = o[g][1] * alpha; lsum[g] *= alpha;
      }
      st[g][0] = st[g][0] - m_old[g]; st[g][1] = st[g][1] - m_old[g];
#pragma unroll
      for (int kt = 0; kt < 2; ++kt)
#pragma unroll
        for (int r = 0; r < 16; ++r) { st[g][kt][r] = __builtin_amdgcn_exp2f(st[g][kt][r]); lsum[g] += st[g][kt][r]; }
    }
#pragma unroll
    for (int kt = 0; kt < 2; ++kt)
#pragma unroll
      for (int s2 = 0; s2 < 2; ++s2) {
        bf16x8 pf[2];
#pragma unroll
        for (int g = 0; g < 2; ++g) {
          uint4 pk = make_uint4(pack2(st[g][kt][8 * s2 + 0], st[g][kt][8 * s2 + 1]), pack2(st[g][kt][8 * s2 + 2], st[g][kt][8 * s2 + 3]),
                                pack2(st[g][kt][8 * s2 + 4], st[g][kt][8 * s2 + 5]), pack2(st[g][kt][8 * s2 + 6], st[g][kt][8 * s2 + 7]));
          pf[g] = __builtin_bit_cast(bf16x8, pk);
        }
#pragma unroll
        for (int dt = 0; dt < 2; ++dt) {
          const unsigned char* va = sV + (dt * 32 + ql) * AV_ST + (kt * 32 + 16 * s2 + 4 * h) * 2;
          const uint2 lo = *(const uint2*)va, hi = *(const uint2*)(va + 16);
          const uint4 vv = make_uint4(lo.x, lo.y, hi.x, hi.y);
          const bf16x8 vf = __builtin_bit_cast(bf16x8, vv);
          o[0][dt] = MFMA32(vf, pf[0], o[0][dt]);
          o[1][dt] = MFMA32(vf, pf[1], o[1][dt]);
        }
      }
    if (j + 1 < NT) {
      unsigned char* wk = smem + ((j + 1) & 1) * ABUF + wko; unsigned char* wv = smem + ((j + 1) & 1) * ABUF + wvo;
      *(u32x4*)wk = rk0; *(u32x4*)(wk + 32 * AK_ST) = rk1;
      *(u32x2*)wv = rv0.xy; *(u32x2*)(wv + 8) = rv0.zw; *(u32x2*)(wv + 32 * AV_ST) = rv1.xy; *(u32x2*)(wv + 32 * AV_ST + 8) = rv1.zw;
    }
    asm volatile("s_waitcnt vmcnt(0)" ::: "memory");
    __syncthreads();
  }
  int tokl = b * S + qb * 256 + wave * 64 + ql;
  asm volatile("" : "+v"(tokl));
#pragma unroll
  for (int g = 0; g < 2; ++g) {
    const float lt = lsum[g] + __shfl_xor(lsum[g], 32);
    const float il = 1.f / lt;
    bf16_t* Op = (bf16_t*)(p.ws + OFF_CAT) + (size_t)(tokl + g * 32) * 1024 + head * 64;
#pragma unroll
    for (int dt = 0; dt < 2; ++dt)
#pragma unroll
      for (int q4 = 0; q4 < 4; ++q4) {
        const uint2 w2 = make_uint2(pack2(o[g][dt][4 * q4] * il, o[g][dt][4 * q4 + 1] * il), pack2(o[g][dt][4 * q4 + 2] * il, o[g][dt][4 * q4 + 3] * il));
        *(uint2*)(Op + dt * 32 + 8 * q4 + 4 * h) = w2;
      }
  }
}

DI void phase_attn_pool(const Params& p, unsigned char* smem) {
  constexpr int N_ATT = NB_ * 8 * 16, N_POOL = 64 * 4;
  const int x = blockIdx.x & 7, j = blockIdx.x >> 3, nper = gridDim.x >> 3;
  const int n_i = (N_LATE - late_n_early() + gridDim.x - 1) / gridDim.x;
  float* sm = (float*)smem;
  int done = 0;
  for (int k = j; k < N_ATT / 8; k += nper) {
    const int take = min(n_i - done, 67);
    attn_item(p, (x >> 1) * 128 + ((x & 1) * 4 + (k >> 4)) * 16 + (k & 15), smem, done, take);
    done += take;
  }
  cvt_late_range(p, done, n_i, sm);
  int tidl = threadIdx.x;
  asm volatile("" : "+v"(tidl));
  const int lrow = tidl >> 2;
  for (int k = j; k < N_POOL / 8; k += nper) {
    const int t = k * 8 + x, rt = t >> 2, g = t & 3;
    {
      const bf16_t* P = (const bf16_t*)(p.ws + OFF_P);
      bf16_t* PO = (bf16_t*)(p.ws + OFF_POOLED);
#pragma unroll 1
      for (int i = 0; i < 16; ++i) {
        const int idx = tidl + 256 * i, row = rt * 256 + (idx >> 4), c8 = g * 128 + (idx & 15) * 8;
        if (g == 0) pooled_one<1>(P, PO, row, c8);
        else if (g == 1) pooled_one<2>(P, PO, row, c8);
        else if (g == 2) pooled_one<4>(P, PO, row, c8);
        else pooled_one<8>(P, PO, row, c8);
      }
      asm volatile("s_waitcnt vmcnt(0)" ::: "memory");
      __syncthreads();
    }
    unsigned a_off[4];
#pragma unroll
    for (int i = 0; i < 4; ++i) a_off[i] = (unsigned)(rt * 256 + lrow + 64 * i) * 512 + g * 128;
    const bf16_t* B = (const bf16_t*)(p.ws + OFF_WT_POOL) + g * 16384;
    EpiStore e; e.dst = (bf16_t*)(p.ws + OFF_CAT) + (size_t)rt * 256 * 1024 + 512 + g * 128; e.ld = 1024;
    e.colscale = p.pool_scale + g * 128; e.rowscale = nullptr; e.cmode = 0;
    gemm_tile((const bf16_t*)(p.ws + OFF_POOLED), a_off, B, B + 64 * 128, 128, 128, smem, e);
  }
}

DI void phase_gemm_plain(const bf16_t* A, const bf16_t* Wt, bf16_t* dst, int ncol_tiles, int ldd, unsigned char* smem) {
  const int lrow = threadIdx.x >> 2;
  XCD_LOOP(k, 8 * ncol_tiles) {
    const int rt = 8 * x + k / ncol_tiles, ct = k % ncol_tiles;
    unsigned a_off[4];
#pragma unroll
    for (int i = 0; i < 4; ++i) a_off[i] = (unsigned)(rt * 256 + lrow + 64 * i) * D;
    const bf16_t* B = Wt + (size_t)ct * 128 * D;
    EpiStore e; e.dst = dst + (size_t)rt * 256 * ldd + ct * 128; e.ld = ldd; e.colscale = nullptr; e.rowscale = nullptr; e.cmode = 0;
    gemm_tile(A, a_off, B, B + (size_t)64 * D, D, D, smem, e);
  }
}

DI void phase_ln_mix(const Params& p, int l, unsigned char* smem) {
  const int tid = threadIdx.x, lane = tid & 63, wave = tid >> 6;
  float* wrT = (float*)smem;
  __syncthreads();
  {
    const float* wr = p.w_router + (size_t)l * D * NE;
    for (int i = tid; i < D * NE / 4; i += 256) {
      const float4 v = *(const float4*)(wr + i * 4);
      const int c = i >> 2, e0 = (i & 3) * 4;
      wrT[(e0 + 0) * 1024 + c] = v.x; wrT[(e0 + 1) * 1024 + c] = v.y; wrT[(e0 + 2) * 1024 + c] = v.z; wrT[(e0 + 3) * 1024 + c] = v.w;
    }
  }
  __syncthreads();
  const float* hin = (l == 0) ? p.x : p.out;
  float* hout = (float*)(p.ws + OFF_H1);
  const bf16_t* Y = (const bf16_t*)(p.ws + OFF_Y);
  bf16_t* U = (bf16_t*)(p.ws + OFF_UA);
  float* aff = (float*)(p.ws + OFF_AFF);
  const float* modv = (const float*)(p.ws + OFF_MOD);
  const float* lg = p.ln_mix_g + l * D;
  const float* lb = p.ln_mix_b + l * D;
  const int r0 = (int)(((long long)blockIdx.x * NTOK) / gridDim.x), r1 = (int)(((long long)(blockIdx.x + 1) * NTOK) / gridDim.x);
  const int stride = 4;
  int row = r0 + wave;
  f32x4 LG[4], LB[4], GT[4], SH[4], SC[4];
#pragma unroll
  for (int i = 0; i < 4; ++i) { LG[i] = *(const f32x4*)(lg + lane * 4 + 256 * i); LB[i] = *(const f32x4*)(lb + lane * 4 + 256 * i); }
  int cur_b = -1;
  float4 hv0, hv1, hv2, hv3; u32x2 yv0, yv1, yv2, yv3;
  if (row < r1) {
    const float* hp = hin + (size_t)row * D + lane * 4; const bf16_t* yp = Y + (size_t)row * D + lane * 4;
    { const f32x4 t0_ = __builtin_nontemporal_load((const f32x4*)hp), t1_ = __builtin_nontemporal_load((const f32x4*)(hp + 256)), t2_ = __builtin_nontemporal_load((const f32x4*)(hp + 512)), t3_ = __builtin_nontemporal_load((const f32x4*)(hp + 768));
      hv0 = make_float4(t0_.x, t0_.y, t0_.z, t0_.w); hv1 = make_float4(t1_.x, t1_.y, t1_.z, t1_.w); hv2 = make_float4(t2_.x, t2_.y, t2_.z, t2_.w); hv3 = make_float4(t3_.x, t3_.y, t3_.z, t3_.w); }
    yv0 = *(const u32x2*)yp; yv1 = *(const u32x2*)(yp + 256); yv2 = *(const u32x2*)(yp + 512); yv3 = *(const u32x2*)(yp + 768);
  }
  for (; row < r1; row += stride) {
    const int b = row >> 12, t = row & 4095;
    if (b != cur_b) {
      const float* mb = modv + (size_t)(l * 5 + b) * 6144 + lane * 4;
#pragma unroll
      for (int i = 0; i < 4; ++i) { GT[i] = *(const f32x4*)(mb + 2 * 1024 + 256 * i); SH[i] = *(const f32x4*)(mb + 3 * 1024 + 256 * i); SC[i] = *(const f32x4*)(mb + 4 * 1024 + 256 * i); }
      cur_b = b;
    }
    const float4 ch[4] = {hv0, hv1, hv2, hv3};
    const u32x2 cy[4] = {yv0, yv1, yv2, yv3};
    {
      const int nrow = row + stride;
      if (nrow < r1) {
        const float* hp = hin + (size_t)nrow * D + lane * 4; const bf16_t* yp = Y + (size_t)nrow * D + lane * 4;
        { const f32x4 t0_ = __builtin_nontemporal_load((const f32x4*)hp), t1_ = __builtin_nontemporal_load((const f32x4*)(hp + 256)), t2_ = __builtin_nontemporal_load((const f32x4*)(hp + 512)), t3_ = __builtin_nontemporal_load((const f32x4*)(hp + 768));
      hv0 = make_float4(t0_.x, t0_.y, t0_.z, t0_.w); hv1 = make_float4(t1_.x, t1_.y, t1_.z, t1_.w); hv2 = make_float4(t2_.x, t2_.y, t2_.z, t2_.w); hv3 = make_float4(t3_.x, t3_.y, t3_.z, t3_.w); }
        yv0 = *(const u32x2*)yp; yv1 = *(const u32x2*)(yp + 256); yv2 = *(const u32x2*)(yp + 512); yv3 = *(const u32x2*)(yp + 768);
      }
    }
    float v[16];
    float sum = 0.f;
#pragma unroll
    for (int i = 0; i < 4; ++i) {
      const int c = lane * 4 + 256 * i;
      const f32x4 gt = GT[i];
      v[4 * i + 0] = ALPHA * ch[i].x + gt.x * bflo(cy[i].x); v[4 * i + 1] = ALPHA * ch[i].y + gt.y * bfhi(cy[i].x);
      v[4 * i + 2] = ALPHA * ch[i].z + gt.z * bflo(cy[i].y); v[4 * i + 3] = ALPHA * ch[i].w + gt.w * bfhi(cy[i].y);
      sum += v[4 * i] + v[4 * i + 1] + v[4 * i + 2] + v[4 * i + 3];
    }
    const float mean = wave_sum(sum) * (1.f / 1024.f);
    float sq = 0.f;
#pragma unroll
    for (int j = 0; j < 16; ++j) { v[j] -= mean; sq += v[j] * v[j]; }
    const float rstd = rsqrtf(wave_sum(sq) * (1.f / 1024.f) + LN_EPS);
#pragma unroll
    for (int i = 0; i < 4; ++i) {
      const int c = lane * 4 + 256 * i;
      const f32x4 g4 = LG[i], b4 = LB[i];
      float4 hn;
      hn.x = v[4 * i] * rstd * g4.x + b4.x; hn.y = v[4 * i + 1] * rstd * g4.y + b4.y;
      hn.z = v[4 * i + 2] * rstd * g4.z + b4.z; hn.w = v[4 * i + 3] * rstd * g4.w + b4.w;
      __builtin_nontemporal_store((f32x4){hn.x, hn.y, hn.z, hn.w}, (f32x4*)(hout + (size_t)row * D + c));
      const f32x4 sh = SH[i], sc4 = SC[i];
      v[4 * i] = hn.x * (1.f + sc4.x) + sh.x; v[4 * i + 1] = hn.y * (1.f + sc4.y) + sh.y;
      v[4 * i + 2] = hn.z * (1.f + sc4.z) + sh.z; v[4 * i + 3] = hn.w * (1.f + sc4.w) + sh.w;
      *(uint2*)(U + (size_t)row * D + c) = make_uint2(pack2(v[4 * i], v[4 * i + 1]), pack2(v[4 * i + 2], v[4 * i + 3]));
    }
    float a[16];
#pragma unroll
    for (int e = 0; e < 16; ++e) {
      float acc = 0.f;
#pragma unroll
      for (int i = 0; i < 4; ++i) {
        const float4 w4 = *(const float4*)(wrT + e * 1024 + lane * 4 + 256 * i);
        acc += v[4 * i] * w4.x + v[4 * i + 1] * w4.y + v[4 * i + 2] * w4.z + v[4 * i + 3] * w4.w;
      }
      a[e] = acc;
      if ((e & 3) == 3) asm volatile("" ::: "memory");
    }
    const bool b5 = (lane & 32) != 0, b4_ = (lane & 16) != 0, b3 = (lane & 8) != 0, b2 = (lane & 4) != 0;
    float r8[8], r4[4], r2[2];
#pragma unroll
    for (int i = 0; i < 8; ++i) { const float snd = b5 ? a[i] : a[i + 8]; const float kp = b5 ? a[i + 8] : a[i]; r8[i] = kp + __shfl_xor(snd, 32); }
#pragma unroll
    for (int i = 0; i < 4; ++i) { const float snd = b4_ ? r8[i] : r8[i + 4]; const float kp = b4_ ? r8[i + 4] : r8[i]; r4[i] = kp + __shfl_xor(snd, 16); }
#pragma unroll
    for (int i = 0; i < 2; ++i) { const float snd = b3 ? r4[i] : r4[i + 2]; const float kp = b3 ? r4[i + 2] : r4[i]; r2[i] = kp + __shfl_xor(snd, 8); }
    float lgt;
    { const float snd = b2 ? r2[0] : r2[1]; const float kp = b2 ? r2[1] : r2[0]; lgt = kp + __shfl_xor(snd, 4); }
    lgt += __shfl_xor(lgt, 2); lgt += __shfl_xor(lgt, 1);
    float mx = lgt;
    mx = fmaxf(mx, __shfl_xor(mx, 4)); mx = fmaxf(mx, __shfl_xor(mx, 8)); mx = fmaxf(mx, __shfl_xor(mx, 16)); mx = fmaxf(mx, __shfl_xor(mx, 32));
    const float ex = expf(lgt - mx);
    float se = ex;
    se += __shfl_xor(se, 4); se += __shfl_xor(se, 8); se += __shfl_xor(se, 16); se += __shfl_xor(se, 32);
    if ((lane & 3) == 0) aff[(size_t)(b * 16 + ((lane >> 2) & 15)) * S + t] = ex / se;
  }
}

DI void phase_topk(const Params& p, unsigned char* smem) {
  const int tid = threadIdx.x, lane = tid & 63, wave = tid >> 6;
  unsigned* hist = (unsigned*)smem;
  unsigned* wtot = hist + 256;
  const float* aff = (const float*)(p.ws + OFF_AFF);
  int* idx = (int*)(p.ws + OFF_IDX);
  float* gatev = (float*)(p.ws + OFF_GATEV);
  int* inv = (int*)(p.ws + OFF_INV);
  for (int be = blockIdx.x; be < NB_ * NE; be += gridDim.x) {
    const int b = be >> 4, e = be & 15;
    unsigned v[16];
#pragma unroll
    for (int i = 0; i < 4; ++i) {
      const float4 f = *(const float4*)(aff + (size_t)be * S + tid * 16 + i * 4);
      v[4 * i] = __float_as_uint(f.x); v[4 * i + 1] = __float_as_uint(f.y); v[4 * i + 2] = __float_as_uint(f.z); v[4 * i + 3] = __float_as_uint(f.w);
    }
    unsigned prefix = 0, mask = 0; int need = CAP;
#pragma unroll 1
    for (int pass = 0; pass < 4; ++pass) {
      const int shift = 24 - 8 * pass;
      __syncthreads();
      hist[tid] = 0;
      __syncthreads();
#pragma unroll
      for (int j = 0; j < 16; ++j) if ((v[j] & mask) == prefix) atomicAdd(&hist[(v[j] >> shift) & 255], 1u);
      __syncthreads();
      {
        const int hcount = (int)hist[tid];
        int sfx = hcount;
#pragma unroll
        for (int o = 1; o < 64; o <<= 1) { const int n = __shfl_down(sfx, o); if (lane + o < 64) sfx += n; }
        if (lane == 0) wtot[wave] = (unsigned)sfx;
        __syncthreads();
        for (int w = wave + 1; w < 4; ++w) sfx += (int)wtot[w];
        if (sfx >= need && sfx - hcount < need) { wtot[4] = (unsigned)tid; wtot[5] = (unsigned)(sfx - hcount); }
        __syncthreads();
        const int bin = (int)wtot[4];
        need -= (int)wtot[5];
        prefix |= (unsigned)bin << shift; mask |= 255u << shift;
      }
    }
    const unsigned T = prefix;
    int cg_ = 0, ce_ = 0;
#pragma unroll
    for (int j = 0; j < 16; ++j) { cg_ += (v[j] > T); ce_ += (v[j] == T); }
    int packed = cg_ | (ce_ << 16);
    int incl = packed;
#pragma unroll
    for (int o = 1; o < 64; o <<= 1) { const int n = __shfl_up(incl, o); if (lane >= o) incl += n; }
    __syncthreads();
    if (lane == 63) wtot[wave] = (unsigned)incl;
    __syncthreads();
    int base = incl - packed;
    for (int w = 0; w < wave; ++w) base += (int)wtot[w];
    int bg = base & 0xffff, beq = base >> 16;
    const int ngt = CAP - need;
#pragma unroll
    for (int j = 0; j < 16; ++j) {
      const int t = tid * 16 + j;
      int slot = -1;
      if (v[j] > T) { slot = bg; ++bg; }
      else if (v[j] == T) { if (beq < need) slot = ngt + beq; ++beq; }
      if (slot >= 0) { idx[be * CAP + slot] = t; gatev[be * CAP + slot] = __uint_as_float(v[j]); }
      inv[(size_t)(b * S + t) * NE + e] = slot;
    }
  }
}

DI void phase_moe_up(const Params& p, int l, unsigned char* smem) {
  const int lrow = threadIdx.x >> 2;
  const int* idx = (const int*)(p.ws + OFF_IDX);
  const bf16_t* U = (const bf16_t*)(p.ws + OFF_UA);
  bf16_t* act = (bf16_t*)(p.ws + OFF_ACT);
  const int x = blockIdx.x & 7, nper = gridDim.x >> 3;
  int k = blockIdx.x >> 3;
  int ni0 = 0, ni1 = 0, ni2 = 0, ni3 = 0;
  if (k < 256) {
    const int e = 4 * (k >> 6) + (x >> 1), m = k & 7, be = (m >> 1) * 16 + e;
    const int* ip = idx + be * CAP + (m & 1) * 256 + lrow;
    ni0 = ip[0]; ni1 = ip[64]; ni2 = ip[128]; ni3 = ip[192];
  }
  for (; k < 256; k += nper) {
    const int e = 4 * (k >> 6) + (x >> 1), m = k & 7, ct = (x & 1) * 8 + ((k >> 3) & 7);
    const int b = m >> 1, rt = m & 1, be = b * 16 + e;
    unsigned a_off[4] = {(unsigned)(b * S + ni0) * D, (unsigned)(b * S + ni1) * D, (unsigned)(b * S + ni2) * D, (unsigned)(b * S + ni3) * D};
    {
      const int kn = k + nper;
      if (kn < 256) {
        const int en = 4 * (kn >> 6) + (x >> 1), mn = kn & 7, ben = (mn >> 1) * 16 + en;
        const int* ip = idx + ben * CAP + (mn & 1) * 256 + lrow;
        ni0 = ip[0]; ni1 = ip[64]; ni2 = ip[128]; ni3 = ip[192];
      }
    }
    const size_t wo = ((size_t)(l * 16 + e) * 1024 + ct * 64) * 1024;
    EpiStore ep; ep.dst = act + ((size_t)be * CAP + rt * 256) * FF + ct * 64; ep.ld = FF; ep.colscale = nullptr; ep.rowscale = nullptr; ep.cmode = 1;
    gemm_tile(U, a_off, (const bf16_t*)(p.ws + OFF_WT_G) + wo, (const bf16_t*)(p.ws + OFF_WT_U) + wo, D, D, smem, ep);
  }
}
DI void phase_moe_down(const Params& p, int l, unsigned char* smem) {
  const int lrow = threadIdx.x >> 2;
  const bf16_t* act = (const bf16_t*)(p.ws + OFF_ACT);
  bf16_t* Y2 = (bf16_t*)(p.ws + OFF_Y2);
  const float* gatev = (const float*)(p.ws + OFF_GATEV);
  XCD_LOOP(k, 128) {
    const int e = 8 * (k >> 6) + x, m = k & 7, ct = (k >> 3) & 7;
    const int b = m >> 1, rt = m & 1, be = b * 16 + e;
    unsigned a_off[4];
#pragma unroll
    for (int i = 0; i < 4; ++i) a_off[i] = (unsigned)(be * CAP + rt * 256 + lrow + 64 * i) * FF;
    const bf16_t* B = (const bf16_t*)(p.ws + OFF_WT_D) + ((size_t)(l * 16 + e) * 1024 + ct * 128) * 1024;
    EpiStore ep; ep.dst = Y2 + ((size_t)be * CAP + rt * 256) * D + ct * 128; ep.ld = D; ep.colscale = nullptr;
    ep.rowscale = gatev + be * CAP + rt * 256; ep.cmode = 0;
    gemm_tile(act, a_off, B, B + (size_t)64 * FF, FF, FF, smem, ep);
  }
}

DI void phase_ln_ffn(const Params& p, int l) {
  const int tid = threadIdx.x, lane = tid & 63, wave = tid >> 6;
  const float* hin = (const float*)(p.ws + OFF_H1);
  float* hout = p.out;
  const bf16_t* Y2 = (const bf16_t*)(p.ws + OFF_Y2);
  const int* inv = (const int*)(p.ws + OFF_INV);
  bf16_t* U = (bf16_t*)(p.ws + OFF_UB);
  const float* modv = (const float*)(p.ws + OFF_MOD);
  const float* lg = p.ln_ffn_g + l * D;
  const float* lb = p.ln_ffn_b + l * D;
  const int r0 = (int)(((long long)blockIdx.x * NTOK) / gridDim.x), r1 = (int)(((long long)(blockIdx.x + 1) * NTOK) / gridDim.x);
  const int stride = 4;
  int row = r0 + wave;
  f32x4 LG[4], LB[4], GT[4], SH[4], SC[4];
#pragma unroll
  for (int i = 0; i < 4; ++i) { LG[i] = *(const f32x4*)(lg + lane * 4 + 256 * i); LB[i] = *(const f32x4*)(lb + lane * 4 + 256 * i); SH[i] = LG[i]; SC[i] = LG[i]; }
  int cur_b = -1;
  float4 hv0, hv1, hv2, hv3; int nslot = -1;
  if (row < r1) {
    const float* hp = hin + (size_t)row * D + lane * 4;
    { const f32x4 t0_ = __builtin_nontemporal_load((const f32x4*)hp), t1_ = __builtin_nontemporal_load((const f32x4*)(hp + 256)), t2_ = __builtin_nontemporal_load((const f32x4*)(hp + 512)), t3_ = __builtin_nontemporal_load((const f32x4*)(hp + 768));
      hv0 = make_float4(t0_.x, t0_.y, t0_.z, t0_.w); hv1 = make_float4(t1_.x, t1_.y, t1_.z, t1_.w); hv2 = make_float4(t2_.x, t2_.y, t2_.z, t2_.w); hv3 = make_float4(t3_.x, t3_.y, t3_.z, t3_.w); }
    nslot = (lane < 16) ? inv[(size_t)row * NE + lane] : -1;
  }
  for (; row < r1; row += stride) {
    const int b = row >> 12;
    if (b != cur_b) {
      const float* mb = modv + (size_t)(l * 5 + b) * 6144 + lane * 4;
      const float* mn = modv + (size_t)(5 + b) * 6144 + lane * 4;
#pragma unroll
      for (int i = 0; i < 4; ++i) {
        GT[i] = *(const f32x4*)(mb + 5 * 1024 + 256 * i);
        if (l == 0) { SH[i] = *(const f32x4*)(mn + 256 * i); SC[i] = *(const f32x4*)(mn + 1024 + 256 * i); }
      }
      cur_b = b;
    }
    const float4 ch[4] = {hv0, hv1, hv2, hv3};
    const int myslot = nslot;
    {
      const int nrow = row + stride;
      if (nrow < r1) {
        const float* hp = hin + (size_t)nrow * D + lane * 4;
        { const f32x4 t0_ = __builtin_nontemporal_load((const f32x4*)hp), t1_ = __builtin_nontemporal_load((const f32x4*)(hp + 256)), t2_ = __builtin_nontemporal_load((const f32x4*)(hp + 512)), t3_ = __builtin_nontemporal_load((const f32x4*)(hp + 768));
      hv0 = make_float4(t0_.x, t0_.y, t0_.z, t0_.w); hv1 = make_float4(t1_.x, t1_.y, t1_.z, t1_.w); hv2 = make_float4(t2_.x, t2_.y, t2_.z, t2_.w); hv3 = make_float4(t3_.x, t3_.y, t3_.z, t3_.w); }
        nslot = (lane < 16) ? inv[(size_t)nrow * NE + lane] : -1;
      }
    }
    float f[16];
#pragma unroll
    for (int j = 0; j < 16; ++j) f[j] = 0.f;
    unsigned m = (unsigned)__ballot(myslot >= 0);
    const bf16_t* ybase = Y2 + (size_t)b * 16 * CAP * D + lane * 4;
    while (m) {
      int e0 = __ffs(m) - 1; m &= m - 1;
      int e1 = -1, e2 = -1, e3 = -1;
      if (m) { e1 = __ffs(m) - 1; m &= m - 1; }
      if (m) { e2 = __ffs(m) - 1; m &= m - 1; }
      if (m) { e3 = __ffs(m) - 1; m &= m - 1; }
      const int s0 = __shfl(myslot, e0), s1 = __shfl(myslot, e1 < 0 ? 0 : e1), s2 = __shfl(myslot, e2 < 0 ? 0 : e2), s3 = __shfl(myslot, e3 < 0 ? 0 : e3);
      u32x2 y0[4], y1[4], y2[4], y3[4];
#pragma unroll
      for (int i = 0; i < 4; ++i) { y1[i] = (u32x2){0u, 0u}; y2[i] = (u32x2){0u, 0u}; y3[i] = (u32x2){0u, 0u}; }
      {
        const bf16_t* yr = ybase + ((size_t)e0 * CAP + s0) * D;
#pragma unroll
        for (int i = 0; i < 4; ++i) y0[i] = *(const u32x2*)(yr + 256 * i);
      }
      if (e1 >= 0) { const bf16_t* yr = ybase + ((size_t)e1 * CAP + s1) * D;
#pragma unroll
        for (int i = 0; i < 4; ++i) y1[i] = *(const u32x2*)(yr + 256 * i); }
      if (e2 >= 0) { const bf16_t* yr = ybase + ((size_t)e2 * CAP + s2) * D;
#pragma unroll
        for (int i = 0; i < 4; ++i) y2[i] = *(const u32x2*)(yr + 256 * i); }
      if (e3 >= 0) { const bf16_t* yr = ybase + ((size_t)e3 * CAP + s3) * D;
#pragma unroll
        for (int i = 0; i < 4; ++i) y3[i] = *(const u32x2*)(yr + 256 * i); }
#pragma unroll
      for (int i = 0; i < 4; ++i) {
        f[4 * i] += (bflo(y0[i].x) + bflo(y1[i].x)) + (bflo(y2[i].x) + bflo(y3[i].x));
        f[4 * i + 1] += (bfhi(y0[i].x) + bfhi(y1[i].x)) + (bfhi(y2[i].x) + bfhi(y3[i].x));
        f[4 * i + 2] += (bflo(y0[i].y) + bflo(y1[i].y)) + (bflo(y2[i].y) + bflo(y3[i].y));
        f[4 * i + 3] += (bfhi(y0[i].y) + bfhi(y1[i].y)) + (bfhi(y2[i].y) + bfhi(y3[i].y));
      }
    }
    float v[16];
    float sum = 0.f;
#pragma unroll
    for (int i = 0; i < 4; ++i) {
      const int c = lane * 4 + 256 * i;
      const f32x4 gt = GT[i];
      v[4 * i + 0] = ALPHA * ch[i].x + gt.x * f[4 * i]; v[4 * i + 1] = ALPHA * ch[i].y + gt.y * f[4 * i + 1];
      v[4 * i + 2] = ALPHA * ch[i].z + gt.z * f[4 * i + 2]; v[4 * i + 3] = ALPHA * ch[i].w + gt.w * f[4 * i + 3];
      sum += v[4 * i] + v[4 * i + 1] + v[4 * i + 2] + v[4 * i + 3];
    }
    const float mean = wave_sum(sum) * (1.f / 1024.f);
    float sq = 0.f;
#pragma unroll
    for (int j = 0; j < 16; ++j) { v[j] -= mean; sq += v[j] * v[j]; }
    const float rstd = rsqrtf(wave_sum(sq) * (1.f / 1024.f) + LN_EPS);
#pragma unroll
    for (int i = 0; i < 4; ++i) {
      const int c = lane * 4 + 256 * i;
      const f32x4 g4 = LG[i], b4 = LB[i];
      float4 hn;
      hn.x = v[4 * i] * rstd * g4.x + b4.x; hn.y = v[4 * i + 1] * rstd * g4.y + b4.y;
      hn.z = v[4 * i + 2] * rstd * g4.z + b4.z; hn.w = v[4 * i + 3] * rstd * g4.w + b4.w;
      __builtin_nontemporal_store((f32x4){hn.x, hn.y, hn.z, hn.w}, (f32x4*)(hout + (size_t)row * D + c));
      if (l == 0) {
        const f32x4 sh = SH[i], sc4 = SC[i];
        *(uint2*)(U + (size_t)row * D + c) = make_uint2(pack2(hn.x * (1.f + sc4.x) + sh.x, hn.y * (1.f + sc4.y) + sh.y),
                                                        pack2(hn.z * (1.f + sc4.z) + sh.z, hn.w * (1.f + sc4.w) + sh.w));
      }
    }
  }
}

DI void phase_conv_in(const Params& p, unsigned char* smem) {
  const int lrow = threadIdx.x >> 2;
  const bf16_t* U = (const bf16_t*)(p.ws + OFF_UB);
  const bf16_t* Wt = (const bf16_t*)(p.ws + OFF_WT_CIN);
  XCD_LOOP(k, 192) {
    const int rt = 8 * x + k / 24, cc = k % 24;
    unsigned a_off[4];
#pragma unroll
    for (int i = 0; i < 4; ++i) a_off[i] = (unsigned)(rt * 256 + lrow + 64 * i) * D;
    EpiStore ep; ep.ld = D; ep.colscale = nullptr; ep.rowscale = nullptr;
    if (cc < 16) {
      ep.dst = (bf16_t*)(p.ws + OFF_CX) + (size_t)rt * 256 * D + cc * 64; ep.cmode = 2;
      gemm_tile(U, a_off, Wt + (size_t)(1024 + cc * 64) * D, Wt + (size_t)(2048 + cc * 64) * D, D, D, smem, ep);
    } else {
      const int ct = cc - 16;
      ep.dst = (bf16_t*)(p.ws + OFF_BG) + (size_t)rt * 256 * D + ct * 128; ep.cmode = 0;
      const bf16_t* B = Wt + (size_t)(ct * 128) * D;
      gemm_tile(U, a_off, B, B + (size_t)64 * D, D, D, smem, ep);
    }
  }
}
DI void phase_conv_gate(const Params& p) {
  const bf16_t* BG = (const bf16_t*)(p.ws + OFF_BG);
  const bf16_t* CX = (const bf16_t*)(p.ws + OFF_CX);
  bf16_t* Z = (bf16_t*)(p.ws + OFF_Z);
  const int total = NTOK * 128;
  for (int i = blockIdx.x * 256 + threadIdx.x; i < total; i += gridDim.x * 256) {
    const int row = i >> 7, c8 = (i & 127) * 8, t = row & 4095;
    float xm[8], x0[8], xp[8], bg[8], z[8];
    unpack8(*(const uint4*)(CX + (size_t)row * D + c8), x0);
    if (t > 0) unpack8(*(const uint4*)(CX + (size_t)(row - 1) * D + c8), xm);
    else {
#pragma unroll
      for (int j = 0; j < 8; ++j) xm[j] = 0.f; }
    if (t < S - 1) unpack8(*(const uint4*)(CX + (size_t)(row + 1) * D + c8), xp);
    else {
#pragma unroll
      for (int j = 0; j < 8; ++j) xp[j] = 0.f; }
    unpack8(*(const uint4*)(BG + (size_t)row * D + c8), bg);
#pragma unroll
    for (int j = 0; j < 8; ++j)
      z[j] = bg[j] * (p.conv_w[c8 + j] * xm[j] + p.conv_w[1024 + c8 + j] * x0[j] + p.conv_w[2048 + c8 + j] * xp[j]);
    *(uint4*)(Z + (size_t)row * D + c8) = pack8(z);
  }
}

#define XB_TMO      128
#define XB_XCNT(j)  (256  + 64 * (j))
#define XB_XSUB(j)  (1280 + 64 * (j))
#define XB_XGEN(j)  (2304 + 64 * (j))
#define XB_TOP      3328
#define XB_TOPGEN   3392
#define XCD_BAR_WORDS 3456
#define XB_SPIN_CAP (1u << 20)
DI unsigned xb_ld(unsigned* p) { return __hip_atomic_load(p, __ATOMIC_RELAXED, __HIP_MEMORY_SCOPE_AGENT); }
DI unsigned xb_add(unsigned* p, unsigned v) { return __hip_atomic_fetch_add(p, v, __ATOMIC_RELAXED, __HIP_MEMORY_SCOPE_AGENT); }
DI unsigned xb_xcc_id() { return (unsigned)__builtin_amdgcn_s_getreg((3 << 11) | 20) & 0xFu; }
#define XB_SPIN(cond, bar) do { unsigned _sp = 0; while (cond) { __builtin_amdgcn_s_sleep(1); \
    if ((++_sp & 255u) == 0u) { if (xb_ld(&(bar)[XB_TMO])) break; if (_sp > XB_SPIN_CAP) { atomicAdd(&(bar)[XB_TMO], 1u); break; } } } } while (0)
struct XcdBarrier { unsigned* bar; unsigned x; volatile unsigned* st; };
DI XcdBarrier xcd_barrier_post(unsigned* bar, volatile unsigned* st) {
  XcdBarrier b; b.bar = bar; b.x = xb_xcc_id(); b.st = st;
  if (threadIdx.x == 0) (void)xb_add(&bar[XB_XCNT(b.x)], 1u);
  return b;
}
DI void xcd_barrier_complete(unsigned* bar, unsigned x, unsigned& nloc, unsigned& nx) {
  const unsigned G = gridDim.x;
  unsigned sum, cnt, mine, sp = 0u;
  for (;;) {
    sum = 0u; cnt = 0u; mine = 0u;
#pragma unroll
    for (unsigned j = 0; j < 16; ++j) { const unsigned c = xb_ld(&bar[XB_XCNT(j)]); sum += c; cnt += (c > 0u) ? 1u : 0u; mine = (j == x) ? c : mine; }
    if (sum == G) break;
    __builtin_amdgcn_s_sleep(1);
    if ((++sp & 255u) == 0u) { if (xb_ld(&bar[XB_TMO])) break; if (sp > XB_SPIN_CAP) { atomicAdd(&bar[XB_TMO], 1u); break; } }
  }
  nloc = mine > 0u ? mine : 1u; nx = cnt > 0u ? cnt : 1u;
}
DI void xcd_barrier(const XcdBarrier& b) {
  asm volatile("s_waitcnt vmcnt(0)" ::: "memory");
  __syncthreads();
  if (threadIdx.x == 0) {
    unsigned* bar = b.bar;
    __builtin_amdgcn_s_waitcnt(0);
    unsigned nloc = b.st[0], nx = b.st[1];
    if (nloc == 0u) { xcd_barrier_complete(bar, b.x, nloc, nx); b.st[0] = nloc; b.st[1] = nx; }
    const unsigned old = xb_add(&bar[XB_XSUB(b.x)], 1u);
    const unsigned gen = old / nloc;
    if (old + 1u == (gen + 1u) * nloc) {
      __builtin_amdgcn_fence(__ATOMIC_RELEASE, "agent");
      asm volatile("s_waitcnt vmcnt(0)" ::: "memory");
      const unsigned og = xb_add(&bar[XB_TOP], 1u);
      const unsigned tg = og / nx;
      if (og + 1u == (tg + 1u) * nx) xb_add(&bar[XB_TOPGEN], 1u);
      else XB_SPIN(xb_ld(&bar[XB_TOPGEN]) == tg, bar);
      __builtin_amdgcn_fence(__ATOMIC_ACQUIRE, "agent");
      xb_add(&bar[XB_XGEN(b.x)], 1u);
      asm volatile("s_waitcnt vmcnt(0)" ::: "memory");
    } else {
      XB_SPIN(xb_ld(&bar[XB_XGEN(b.x)]) == gen, bar);
      __builtin_amdgcn_fence(__ATOMIC_ACQUIRE, "agent");
      asm volatile("s_waitcnt vmcnt(0)" ::: "memory");
    }
  }
  __syncthreads();
}

__global__ void __launch_bounds__(256, 2) fwd_megakernel(Params p) {
  extern __shared__ __attribute__((aligned(16))) unsigned char smem[];
  cg::grid_group grid = cg::this_grid();
  if (p.ph_lo < 0) grid.sync();
  volatile unsigned* xst = (volatile unsigned*)(smem + LDS_BYTES - 16);
  if (threadIdx.x == 0) { xst[0] = 0u; xst[1] = 0u; }
  __syncthreads();
  XcdBarrier xb = xcd_barrier_post((unsigned*)(p.ws + OFF_BAR), xst);
#ifndef DUPMASK
#define DUPMASK 0u
#endif
#define PH(n, call) if (p.ph_lo <= (n) && (n) < p.ph_hi) { call; if ((DUPMASK >> (n)) & 1u) { xcd_barrier(xb); call; } if ((n) + 1 < p.ph_hi) xcd_barrier(xb); }
  PH(0, phase_prologue(p, smem))
  PH(1, phase_mod_input(p))
  PH(2, phase_inproj(p, smem))
  PH(4, phase_attn_pool(p, smem))
  PH(5, phase_gemm_plain((const bf16_t*)(p.ws + OFF_CAT), (const bf16_t*)(p.ws + OFF_WT_OUT), (bf16_t*)(p.ws + OFF_Y), 8, D, smem))
  PH(6, phase_ln_mix(p, 0, smem))
  PH(7, phase_topk(p, smem))
  PH(8, phase_moe_up(p, 0, smem))
  PH(9, phase_moe_down(p, 0, smem))
  PH(10, phase_ln_ffn(p, 0))
  PH(11, phase_conv_in(p, smem))
  PH(12, phase_conv_gate(p))
  PH(13, phase_gemm_plain((const bf16_t*)(p.ws + OFF_Z), (const bf16_t*)(p.ws + OFF_WT_COUT), (bf16_t*)(p.ws + OFF_Y), 8, D, smem))
  PH(14, phase_ln_mix(p, 1, smem))
  PH(15, phase_topk(p, smem))
  PH(16, phase_moe_up(p, 1, smem))
  PH(17, phase_moe_down(p, 1, smem))
  PH(18, phase_ln_ffn(p, 1))
#undef PH
}

extern "C" void kernel_launch(void* const* d_in, const int* in_sizes, int n_in, void* d_out, int out_size, void* d_ws,
                              size_t ws_size, hipStream_t stream) {
  static int grid_blocks = 0;
  if (!grid_blocks) {
    if (n_in != 23 || ws_size < WS_END) { fprintf(stderr, "kernel_launch: unexpected n_in %d or ws_size %zu (need %zu)\n", n_in, ws_size, (size_t)WS_END); grid_blocks = -1; return; }
    int dev = 0, cus = 0, per_cu = 0;
    hipGetDevice(&dev);
    hipDeviceGetAttribute(&cus, hipDeviceAttributeMultiprocessorCount, dev);
    if (hipFuncSetAttribute((const void*)fwd_megakernel, hipFuncAttributeMaxDynamicSharedMemorySize, LDS_BYTES) != hipSuccess) { fprintf(stderr, "kernel_launch: hipFuncSetAttribute(%d B dynamic LDS) failed\n", LDS_BYTES); grid_blocks = -1; return; }
    hipOccupancyMaxActiveBlocksPerMultiprocessor(&per_cu, fwd_megakernel, 256, LDS_BYTES);
    if (per_cu < 1) per_cu = 1;
    if (per_cu > 2) per_cu = 2;
    grid_blocks = cus * per_cu;
  }
  if (grid_blocks < 0) return;
  Params p{};
  const float** f = (const float**)&p;
  for (int i = 0; i < 23; ++i) f[i] = (const float*)d_in[i];
  p.out = (float*)d_out; p.ws = (unsigned char*)d_ws; p.ph_lo = 0; p.ph_hi = 19;
  (void)hipMemsetAsync((unsigned char*)d_ws + OFF_BAR, 0, 16384, stream);
  void* args[] = {&p};
  hipError_t e = hipLaunchCooperativeKernel((void*)fwd_megakernel, dim3(grid_blocks), dim3(256), args, LDS_BYTES, stream);
  if (e != hipSuccess) fprintf(stderr, "cooperative launch failed: %s (grid %d)\n", hipGetErrorString(e), grid_blocks);
}
```

```cpp
#include <hip/hip_runtime.h>
#include <hip/hip_cooperative_groups.h>
#include <cstdio>
namespace cg = cooperative_groups;

typedef unsigned short bf16_t;
using bf16x8 = __attribute__((ext_vector_type(8))) short;
using f32x16 = __attribute__((ext_vector_type(16))) float;
typedef unsigned u32x4 __attribute__((ext_vector_type(4)));
typedef unsigned u32x2 __attribute__((ext_vector_type(2)));
typedef float f32x4 __attribute__((ext_vector_type(4)));
#define DI __device__ __forceinline__
#define MFMA32(a, b, c) __builtin_amdgcn_mfma_f32_32x32x16_bf16((a), (b), (c), 0, 0, 0)

constexpr int D = 1024, NB_ = 4, S = 4096, NTOK = NB_ * S, CTXL = 256, NCTX = NB_ * CTXL;
constexpr int NKEY = S + CTXL;
constexpr int NE = 16, CAP = 512, FF = 1024;
constexpr float LN_EPS = 1e-6f;
constexpr float QSCALE = 0.125f * 1.4426950408889634f;
constexpr float ALPHA = 1.41421356237309515f;

constexpr size_t MiB = 1ull << 20;
constexpr size_t OFF_WT_IN = 0;
constexpr size_t OFF_WT_OUT = OFF_WT_IN + 1280ull * 1024 * 2;
constexpr size_t OFF_WT_POOL = OFF_WT_OUT + 2 * MiB;
constexpr size_t OFF_WT_CIN = OFF_WT_POOL + 4ull * 128 * 128 * 2;
constexpr size_t OFF_WT_COUT = OFF_WT_CIN + 6 * MiB;
constexpr size_t OFF_WT_G = OFF_WT_COUT + 2 * MiB;
constexpr size_t OFF_WT_U = OFF_WT_G + 64 * MiB;
constexpr size_t OFF_WT_D = OFF_WT_U + 64 * MiB;
constexpr size_t OFF_MOD = OFF_WT_D + 64 * MiB;
constexpr size_t OFF_ROPE = OFF_MOD + 2ull * 5 * 6144 * 4;
constexpr size_t OFF_UCTX = OFF_ROPE + 8192;
constexpr size_t OFF_M = OFF_UCTX + 2 * MiB;
constexpr size_t OFF_Q = OFF_M;
constexpr size_t OFF_K = OFF_M + 16 * MiB;
constexpr size_t OFF_VT = OFF_M + 21 * MiB;
constexpr size_t OFF_P = OFF_M + 26 * MiB;
constexpr size_t OFF_POOLED = OFF_M + 42 * MiB;
constexpr size_t OFF_CAT = OFF_M + 58 * MiB;
constexpr size_t OFF_BG = OFF_M;
constexpr size_t OFF_CX = OFF_M + 32 * MiB;
constexpr size_t OFF_Z = OFF_M + 64 * MiB;
constexpr size_t OFF_ACT = OFF_M;
constexpr size_t OFF_UB = OFF_M + 96 * MiB;
constexpr size_t OFF_Y = OFF_M + 128 * MiB;
constexpr size_t OFF_UA = OFF_Y + 32 * MiB;
constexpr size_t OFF_Y2 = OFF_Y;
constexpr size_t OFF_H1 = OFF_UA + 32 * MiB;
constexpr size_t OFF_AFF = OFF_H1 + 64 * MiB;
constexpr size_t OFF_IDX = OFF_AFF + 1 * MiB;
constexpr size_t OFF_GATEV = OFF_IDX + 128 * 1024;
constexpr size_t OFF_INV = OFF_GATEV + 128 * 1024;
constexpr size_t OFF_BAR = OFF_INV + 1 * MiB;
constexpr size_t WS_END = OFF_BAR + 16384;

struct Params {
  const float *x, *c, *ctx, *c_ctx, *w_mod, *b_mod, *ln_mix_g, *ln_mix_b, *ln_ffn_g, *ln_ffn_b;
  const float *w_mix_in, *q_norm_g, *k_norm_g, *w_pool_grp, *pool_scale, *w_mix_out;
  const float *w_conv_in, *conv_w, *w_conv_out, *w_router, *w_exp_gate, *w_exp_up, *w_exp_down;
  float* out;
  unsigned char* ws;
  int ph_lo, ph_hi;
};

DI unsigned pack2(float a, float b) {
  typedef float f2 __attribute__((ext_vector_type(2)));
  typedef __bf16 b2 __attribute__((ext_vector_type(2)));
  f2 v = {a, b};
  b2 r = __builtin_convertvector(v, b2);
  return __builtin_bit_cast(unsigned, r);
}
DI float bflo(unsigned u) { return __uint_as_float(u << 16); }
DI float bfhi(unsigned u) { return __uint_as_float(u & 0xffff0000u); }
DI uint4 pack8(const float* v) { return make_uint4(pack2(v[0], v[1]), pack2(v[2], v[3]), pack2(v[4], v[5]), pack2(v[6], v[7])); }
DI void unpack8(uint4 u, float* v) {
  v[0] = bflo(u.x); v[1] = bfhi(u.x); v[2] = bflo(u.y); v[3] = bfhi(u.y);
  v[4] = bflo(u.z); v[5] = bfhi(u.z); v[6] = bflo(u.w); v[7] = bfhi(u.w);
}
DI int crow(int reg, int h) { return (reg & 3) + 8 * (reg >> 2) + 4 * h; }
DI float wave_sum(float v) {
#pragma unroll
  for (int o = 32; o >= 1; o >>= 1) v += __shfl_xor(v, o);
  return v;
}

constexpr int GST = 144;
constexpr int EST = 132;
constexpr int LDS_BYTES = 3 * 24576 + 16;

constexpr int GROW = 64;
constexpr int GSTG = 384 * GROW;
#define WAIT_VM(n) asm volatile("s_waitcnt vmcnt(" #n ")" ::: "memory")
#define GLDS16(g, l) __builtin_amdgcn_global_load_lds((const unsigned*)(g), (unsigned*)(l), 16, 0, 0)

template <class Epi>
DI void gemm_tile(const bf16_t* A, const unsigned (&a_off)[4], const bf16_t* B0, const bf16_t* B1, int ldb, int K,
                  unsigned char* smem, const Epi& epi) {
  const int tid = threadIdx.x, lane = tid & 63, wave = tid >> 6;
  const int wm = wave >> 1, wn = wave & 1;
  const int lrow = tid >> 2, kc = tid & 3;
  const int ql = lane & 31, h = lane >> 5;
  f32x16 acc[4][2];
#pragma unroll
  for (int mi = 0; mi < 4; ++mi)
#pragma unroll
    for (int ni = 0; ni < 2; ++ni)
#pragma unroll
      for (int r = 0; r < 16; ++r) acc[mi][ni][r] = 0.f;

  const int csrc = (kc ^ ((lrow >> 2) & 3)) * 8;
  const unsigned char* Ab = (const unsigned char*)A;
  const unsigned char* bp0 = (const unsigned char*)(B0 + (size_t)lrow * ldb + csrc);
  const unsigned char* bp1 = (const unsigned char*)(B1 + (size_t)lrow * ldb + csrc);
  unsigned ao[4];
#pragma unroll
  for (int i = 0; i < 4; ++i) ao[i] = (a_off[i] + csrc) * 2u;
  unsigned char* dbase = smem + wave * 1024;
  const int nk = K >> 5;
  WAIT_VM(0);
  __syncthreads();
  {
#pragma unroll
    for (int i = 0; i < 4; ++i) GLDS16(Ab + ao[i], dbase + i * 4096);
    GLDS16(bp0, dbase + 16384); GLDS16(bp1, dbase + 20480);
    const unsigned kb = (nk > 1) ? 64u : 0u;
#pragma unroll
    for (int i = 0; i < 4; ++i) GLDS16(Ab + ao[i] + kb, dbase + GSTG + i * 4096);
    GLDS16(bp0 + kb, dbase + GSTG + 16384); GLDS16(bp1 + kb, dbase + GSTG + 20480);
  }
  const int sw = (ql >> 2) & 3;
  const int o0 = ((0 + h) ^ sw) * 16, o1 = ((2 + h) ^ sw) * 16;
  const int aoffr = (wm * 128 + ql) * GROW;
  const int boffr = 256 * GROW + (wn * 64 + ql) * GROW;
  int cs = 0, ns = 2;
#pragma unroll 1
  for (int kt = 0; kt < nk; ++kt) {
    WAIT_VM(6);
    asm volatile("s_waitcnt lgkmcnt(0)" ::: "memory");
    __builtin_amdgcn_s_barrier();
    const unsigned char* cur = smem + cs * GSTG;
    unsigned char* nd = dbase + ns * GSTG;
    const unsigned kb = (unsigned)min(kt + 2, nk - 1) * 64u;
#pragma unroll
    for (int i = 0; i < 4; ++i) GLDS16(Ab + ao[i] + kb, nd + i * 4096);
    GLDS16(bp0 + kb, nd + 16384); GLDS16(bp1 + kb, nd + 20480);
    bf16x8 af0[4], bf0[2], af1[4], bf1[2];
#pragma unroll
    for (int mi = 0; mi < 4; ++mi) af0[mi] = *(const bf16x8*)(cur + aoffr + mi * 32 * GROW + o0);
#pragma unroll
    for (int ni = 0; ni < 2; ++ni) bf0[ni] = *(const bf16x8*)(cur + boffr + ni * 32 * GROW + o0);
#pragma unroll
    for (int mi = 0; mi < 4; ++mi) af1[mi] = *(const bf16x8*)(cur + aoffr + mi * 32 * GROW + o1);
#pragma unroll
    for (int ni = 0; ni < 2; ++ni) bf1[ni] = *(const bf16x8*)(cur + boffr + ni * 32 * GROW + o1);
#pragma unroll
    for (int mi = 0; mi < 4; ++mi)
#pragma unroll
      for (int ni = 0; ni < 2; ++ni) acc[mi][ni] = MFMA32(af0[mi], bf0[ni], acc[mi][ni]);
#pragma unroll
    for (int mi = 0; mi < 4; ++mi)
#pragma unroll
      for (int ni = 0; ni < 2; ++ni) acc[mi][ni] = MFMA32(af1[mi], bf1[ni], acc[mi][ni]);
    __builtin_amdgcn_sched_group_barrier(0x100, 6, 0);
#pragma unroll
    for (int i = 0; i < 6; ++i) {
      __builtin_amdgcn_sched_group_barrier(0x008, 1, 0);
      __builtin_amdgcn_sched_group_barrier(0x100, 1, 0);
    }
    __builtin_amdgcn_sched_group_barrier(0x008, 10, 0);
    cs = (cs == 2) ? 0 : cs + 1;
    ns = (ns == 2) ? 0 : ns + 1;
  }
  WAIT_VM(0);
  __syncthreads();
  float* st = (float*)smem;
  int tl = tid;
  asm volatile("" : "+v"(tl));
#pragma unroll
  for (int q2 = 0; q2 < 2; ++q2) {
    if (wm == q2) {
#pragma unroll
      for (int mi = 0; mi < 4; ++mi)
#pragma unroll
        for (int ni = 0; ni < 2; ++ni)
#pragma unroll
          for (int r = 0; r < 16; ++r)
            st[(mi * 32 + crow(r, h)) * EST + wn * 64 + ni * 32 + ql] = acc[mi][ni][r];
    }
    __syncthreads();
    epi.process(st, 2 * q2, tl);
    epi.process(st + 64 * EST, 2 * q2 + 1, tl);
    __syncthreads();
  }
}

struct EpiStore {
  bf16_t* dst;
  int ld;
  const float* colscale;
  const float* rowscale;
  int cmode;
  DI void process(const float* st, int hm, int tid) const {
    if (cmode != 0) {
#pragma unroll
      for (int i = 0; i < 2; ++i) {
        const int c = tid + 256 * i, r = c >> 3, cc = c & 7;
        const float4 a0 = *(const float4*)(st + r * EST + cc * 8), a1 = *(const float4*)(st + r * EST + cc * 8 + 4);
        const float4 b0 = *(const float4*)(st + r * EST + 64 + cc * 8), b1 = *(const float4*)(st + r * EST + 64 + cc * 8 + 4);
        float a[8] = {a0.x, a0.y, a0.z, a0.w, a1.x, a1.y, a1.z, a1.w};
        const float b[8] = {b0.x, b0.y, b0.z, b0.w, b1.x, b1.y, b1.z, b1.w};
        if (cmode == 1) {
#pragma unroll
          for (int j = 0; j < 8; ++j) a[j] = a[j] / (1.f + __expf(-a[j])) * b[j];
        } else {
#pragma unroll
          for (int j = 0; j < 8; ++j) a[j] = a[j] * b[j];
        }
        *(uint4*)(dst + (size_t)(hm * 64 + r) * ld + cc * 8) = pack8(a);
      }
      return;
    }
#pragma unroll
    for (int i = 0; i < 4; ++i) {
      const int c = tid + 256 * i, r = c >> 4, cc = c & 15;
      const float4 a = *(const float4*)(st + r * EST + cc * 8);
      const float4 b = *(const float4*)(st + r * EST + cc * 8 + 4);
      float v[8] = {a.x, a.y, a.z, a.w, b.x, b.y, b.z, b.w};
      const int row = hm * 64 + r;
      if (rowscale) { const float rs = rowscale[row];
#pragma unroll
        for (int j = 0; j < 8; ++j) v[j] *= rs; }
      if (colscale) {
#pragma unroll
        for (int j = 0; j < 8; ++j) v[j] *= colscale[cc * 8 + j]; }
      *(uint4*)(dst + (size_t)row * ld + cc * 8) = pack8(v);
    }
  }
};

struct EpiInProj {
  unsigned char* ws;
  const float *qg, *kg;
  int row0;
  int is_ctx;
  int ct;
  DI void process(const float* st, int hm, int tid) const {
    if (ct == 5) {
      bf16_t* Vt = (bf16_t*)(ws + OFF_VT);
#pragma unroll
      for (int i = 0; i < 4; ++i) {
        const int c = tid + 256 * i, d = c >> 3, rc = c & 7;
        float v[8];
#pragma unroll
        for (int j = 0; j < 8; ++j) v[j] = st[(rc * 8 + j) * EST + d];
        const int r = row0 + hm * 64 + rc * 8;
        const int b = is_ctx ? (r >> 8) : (r >> 12);
        const int key = is_ctx ? (r & 255) : (CTXL + (r & 4095));
        *(uint4*)(Vt + ((size_t)((b * 2 + (d >> 6)) * 64 + (d & 63))) * NKEY + key) = pack8(v);
      }
      return;
    }
    const float* cos_t = (const float*)(ws + OFF_ROPE);
    const float* sin_t = cos_t + 1024;
#pragma unroll
    for (int i = 0; i < 4; ++i) {
      const int c = tid + 256 * i, r = c >> 4, cc = c & 15;
      const float4 a = *(const float4*)(st + r * EST + cc * 8);
      const float4 bb = *(const float4*)(st + r * EST + cc * 8 + 4);
      float v[8] = {a.x, a.y, a.z, a.w, bb.x, bb.y, bb.z, bb.w};
      const int grow = row0 + hm * 64 + r;
      if (ct <= 4) {
        float ss = 0.f;
#pragma unroll
        for (int j = 0; j < 8; ++j) ss += v[j] * v[j];
        ss += __shfl_xor(ss, 1); ss += __shfl_xor(ss, 2); ss += __shfl_xor(ss, 4);
        const float rinv = rsqrtf(ss * (1.f / 64.f) + LN_EPS);
        const float* g = (ct < 4 ? qg : kg) + (cc & 7) * 8;
#pragma unroll
        for (int j = 0; j < 8; ++j) v[j] = v[j] * rinv * g[j];
        if (!is_ctx) {
          const int t = grow & 4095, rowp = t >> 6, colp = t & 63;
#pragma unroll
          for (int jj = 0; jj < 4; ++jj) {
            const int pidx = (cc & 7) * 4 + jj;
            const int pos = (pidx < 16) ? rowp : colp;
            const float cs = cos_t[pos * 16 + (pidx & 15)], sn = sin_t[pos * 16 + (pidx & 15)];
            const float x0 = v[2 * jj], x1 = v[2 * jj + 1];
            v[2 * jj] = x0 * cs - x1 * sn;
            v[2 * jj + 1] = x0 * sn + x1 * cs;
          }
        }
        if (ct < 4) {
#pragma unroll
          for (int j = 0; j < 8; ++j) v[j] *= QSCALE;
          *(uint4*)((bf16_t*)(ws + OFF_Q) + (size_t)grow * 512 + ct * 128 + cc * 8) = pack8(v);
        } else {
          const int b = is_ctx ? (grow >> 8) : (grow >> 12);
          const int key = is_ctx ? (grow & 255) : (CTXL + (grow & 4095));
          *(uint4*)((bf16_t*)(ws + OFF_K) + ((size_t)(b * 2 + (cc >> 3)) * NKEY + key) * 64 + (cc & 7) * 8) = pack8(v);
        }
      } else {
        *(uint4*)((bf16_t*)(ws + OFF_P) + (size_t)grow * 512 + (ct - 6) * 128 + cc * 8) = pack8(v);
      }
    }
  }
};

DI void cvt_tile(const float* __restrict__ src, bf16_t* dst, int K, int N, int kt, int nt, float* st) {
  const int tid = threadIdx.x;
  const int k0 = kt * 64, n0 = nt * 64;
  __syncthreads();
#pragma unroll
  for (int i = 0; i < 4; ++i) {
    const int k = (tid >> 4) + 16 * i, n4 = (tid & 15) * 4;
    const f32x4 v = __builtin_nontemporal_load((const f32x4*)(src + (size_t)(k0 + k) * N + n0 + n4));
    st[k * 65 + n4 + 0] = v.x; st[k * 65 + n4 + 1] = v.y; st[k * 65 + n4 + 2] = v.z; st[k * 65 + n4 + 3] = v.w;
  }
  __syncthreads();
#pragma unroll
  for (int i = 0; i < 2; ++i) {
    const int c = tid + 256 * i, n = c >> 3, kc = c & 7;
    float v[8];
#pragma unroll
    for (int j = 0; j < 8; ++j) v[j] = st[(kc * 8 + j) * 65 + n];
    *(uint4*)(dst + (size_t)(n0 + n) * K + k0 + kc * 8) = pack8(v);
  }
}

DI void modgemv_item(const Params& p, int item, float* sm) {
  const int tid = threadIdx.x, lane = tid & 63, wave = tid >> 6;
  const int l = item / 96, n0 = (item % 96) * 64;
  float* red = sm + 5120;
  __syncthreads();
  for (int i = tid; i < 5120; i += 256) {
    const int r = i >> 10, k = i & 1023;
    const float cv = (r < 4) ? p.c[r * 1024 + k] : p.c_ctx[k];
    sm[i] = cv / (1.f + expf(-cv));
  }
  __syncthreads();
  const int sub = lane >> 4, c4 = (lane & 15) * 4;
  f32x4 a0 = {0.f, 0.f, 0.f, 0.f}, a1 = a0, a2 = a0, a3 = a0, a4 = a0;
  const float* w = p.w_mod + (size_t)l * 1024 * 6144 + n0 + c4;
  const int kb = wave * 256 + sub;
#pragma unroll 8
  for (int kk = 0; kk < 64; ++kk) {
    const int k = kb + kk * 4;
    const f32x4 wv = __builtin_nontemporal_load((const f32x4*)(w + (size_t)k * 6144));
    a0 += sm[k] * wv; a1 += sm[1024 + k] * wv; a2 += sm[2048 + k] * wv; a3 += sm[3072 + k] * wv; a4 += sm[4096 + k] * wv;
  }
#pragma unroll
  for (int j = 0; j < 4; ++j) {
    a0[j] += __shfl_xor(a0[j], 16); a0[j] += __shfl_xor(a0[j], 32);
    a1[j] += __shfl_xor(a1[j], 16); a1[j] += __shfl_xor(a1[j], 32);
    a2[j] += __shfl_xor(a2[j], 16); a2[j] += __shfl_xor(a2[j], 32);
    a3[j] += __shfl_xor(a3[j], 16); a3[j] += __shfl_xor(a3[j], 32);
    a4[j] += __shfl_xor(a4[j], 16); a4[j] += __shfl_xor(a4[j], 32);
  }
  if (sub == 0) {
    *(f32x4*)(red + (wave * 5 + 0) * 64 + c4) = a0; *(f32x4*)(red + (wave * 5 + 1) * 64 + c4) = a1; *(f32x4*)(red + (wave * 5 + 2) * 64 + c4) = a2;
    *(f32x4*)(red + (wave * 5 + 3) * 64 + c4) = a3; *(f32x4*)(red + (wave * 5 + 4) * 64 + c4) = a4;
  }
  __syncthreads();
  float* modv = (float*)(p.ws + OFF_MOD);
  for (int o = tid; o < 320; o += 256) {
    const int r = o >> 6, ln = o & 63;
    float s = p.b_mod[l * 6144 + n0 + ln];
#pragma unroll
    for (int w4 = 0; w4 < 4; ++w4) s += red[(w4 * 5 + r) * 64 + ln];
    modv[(size_t)(l * 5 + r) * 6144 + n0 + ln] = s;
  }
}

DI void phase_prologue(const Params& p, unsigned char* smem) {
  constexpr int N_GEMV = 192, N_ROPE = 1;
  constexpr int T_IN = 16 * 20, T_POOL = 16, T_OUT = 256, T_CIN = 16 * 48, T_COUT = 256, T_EXP = 8192;
  constexpr int total = N_GEMV + N_ROPE + T_IN + T_POOL + T_OUT;
  float* sm = (float*)smem;
  for (int it = blockIdx.x; it < total; it += gridDim.x) {
    int t = it;
    if (t < N_GEMV) { modgemv_item(p, t, sm); continue; }
    t -= N_GEMV;
    if (t < N_ROPE) {
      float* cos_t = (float*)(p.ws + OFF_ROPE);
      for (int i = threadIdx.x; i < 1024; i += 256) {
        const int pos = i >> 4, fi = i & 15;
        const float inv = exp2f(-(float)fi * (13.287712379549449f / 16.f));
        const float ang = (float)pos * inv;
        cos_t[i] = cosf(ang); cos_t[1024 + i] = sinf(ang);
      }
      continue;
    }
    t -= N_ROPE;
    if (t < T_IN) { cvt_tile(p.w_mix_in, (bf16_t*)(p.ws + OFF_WT_IN), 1024, 1280, t / 20, t % 20, sm); continue; }
    t -= T_IN;
    if (t < T_POOL) { const int g = t >> 2, r = t & 3;
      cvt_tile(p.w_pool_grp + g * 16384, (bf16_t*)(p.ws + OFF_WT_POOL) + g * 16384, 128, 128, r >> 1, r & 1, sm); continue; }
    t -= T_POOL;
    cvt_tile(p.w_mix_out, (bf16_t*)(p.ws + OFF_WT_OUT), 1024, 1024, t >> 4, t & 15, sm);
  }
}

constexpr int N_LATE = 768 + 256 + 3 * 8192;
DI void cvt_late_tile(const Params& p, int t, float* sm) {
  if (t < 768) { cvt_tile(p.w_conv_in, (bf16_t*)(p.ws + OFF_WT_CIN), 1024, 3072, t / 48, t % 48, sm); return; }
  t -= 768;
  if (t < 256) { cvt_tile(p.w_conv_out, (bf16_t*)(p.ws + OFF_WT_COUT), 1024, 1024, t >> 4, t & 15, sm); return; }
  t -= 256;
  const int which = t >> 13, r = t & 8191, mat = r >> 8, tt = r & 255;
  const float* src = (which == 0 ? p.w_exp_gate : which == 1 ? p.w_exp_up : p.w_exp_down) + (size_t)mat * 1048576;
  bf16_t* dst = (bf16_t*)(p.ws + (which == 0 ? OFF_WT_G : which == 1 ? OFF_WT_U : OFF_WT_D)) + (size_t)mat * 1048576;
  cvt_tile(src, dst, 1024, 1024, tt >> 4, tt & 15, sm);
}
struct CvtDesc { const float* src; bf16_t* dst; int K, N, k0, n0; };
DI CvtDesc cvt_late_desc(const Params& p, int t) {
  CvtDesc d;
  if (t < 768) { d.src = p.w_conv_in; d.dst = (bf16_t*)(p.ws + OFF_WT_CIN); d.K = 1024; d.N = 3072; d.k0 = (t / 48) * 64; d.n0 = (t % 48) * 64; return d; }
  t -= 768;
  if (t < 256) { d.src = p.w_conv_out; d.dst = (bf16_t*)(p.ws + OFF_WT_COUT); d.K = 1024; d.N = 1024; d.k0 = (t >> 4) * 64; d.n0 = (t & 15) * 64; return d; }
  t -= 256;
  const int which = t >> 13, r = t & 8191, mat = r >> 8, tt = r & 255;
  d.src = (which == 0 ? p.w_exp_gate : which == 1 ? p.w_exp_up : p.w_exp_down) + (size_t)mat * 1048576;
  d.dst = (bf16_t*)(p.ws + (which == 0 ? OFF_WT_G : which == 1 ? OFF_WT_U : OFF_WT_D)) + (size_t)mat * 1048576;
  d.K = 1024; d.N = 1024; d.k0 = (tt >> 4) * 64; d.n0 = (tt & 15) * 64;
  return d;
}
DI int late_n_idle() { return 0; }
DI int late_n_early() { return min(14 * late_n_idle(), N_LATE); }
DI void cvt_late_range(const Params& p, int i0, int i1, float* sm) {
  const int base = late_n_early();
  for (int i = i0; i < i1; ++i) { const int t = base + blockIdx.x + i * gridDim.x; if (t < N_LATE) cvt_late_tile(p, t, sm); }
}

DI void phase_mod_input(const Params& p) {
  const float* modv = (const float*)(p.ws + OFF_MOD);
  bf16_t* uA = (bf16_t*)(p.ws + OFF_UA);
  bf16_t* uC = (bf16_t*)(p.ws + OFF_UCTX);
  const int total = (NTOK + NCTX) * 128;
  for (int i = blockIdx.x * 256 + threadIdx.x; i < total; i += gridDim.x * 256) {
    const int row = i >> 7, c8 = (i & 127) * 8;
    const float* src; bf16_t* dst; int mr;
    if (row < NTOK) { src = p.x + (size_t)row * D + c8; dst = uA + (size_t)row * D + c8; mr = row >> 12; }
    else { const int r = row - NTOK; src = p.ctx + (size_t)r * D + c8; dst = uC + (size_t)r * D + c8; mr = 4; }
    const float* sh = modv + (size_t)mr * 6144 + c8;
    const float* sc = sh + 1024;
    const float4 a = *(const float4*)src, b = *(const float4*)(src + 4);
    const float4 s0 = *(const float4*)sh, s1 = *(const float4*)(sh + 4);
    const float4 c0 = *(const float4*)sc, c1 = *(const float4*)(sc + 4);
    float v[8] = {a.x * (1.f + c0.x) + s0.x, a.y * (1.f + c0.y) + s0.y, a.z * (1.f + c0.z) + s0.z, a.w * (1.f + c0.w) + s0.w,
                  b.x * (1.f + c1.x) + s1.x, b.y * (1.f + c1.y) + s1.y, b.z * (1.f + c1.z) + s1.z, b.w * (1.f + c1.w) + s1.w};
    *(uint4*)dst = pack8(v);
  }
}

#define XCD_LOOP(k, n_x) const int x = blockIdx.x & 7, nper_ = gridDim.x >> 3; for (int k = blockIdx.x >> 3; k < (n_x); k += nper_)

DI void phase_inproj(const Params& p, unsigned char* smem) {
  const bf16_t* Wt = (const bf16_t*)(p.ws + OFF_WT_IN);
  const int lrow = threadIdx.x >> 2;
  XCD_LOOP(k, 81) {
    EpiInProj e; e.ws = p.ws; e.qg = p.q_norm_g; e.kg = p.k_norm_g;
    const bf16_t* A; int rt, ct;
    if (k < 80) { rt = 8 * x + k / 10; ct = k % 10; A = (const bf16_t*)(p.ws + OFF_UA); e.is_ctx = 0; }
    else { rt = x >> 1; ct = 4 + (x & 1); A = (const bf16_t*)(p.ws + OFF_UCTX); e.is_ctx = 1; }
    e.row0 = rt * 256; e.ct = ct;
    unsigned a_off[4];
#pragma unroll
    for (int i = 0; i < 4; ++i) a_off[i] = (unsigned)(rt * 256 + lrow + 64 * i) * D;
    const bf16_t* B = Wt + (size_t)ct * 128 * D;
    gemm_tile(A, a_off, B, B + (size_t)64 * D, D, D, smem, e);
  }
  {
    const int nper = gridDim.x >> 3, j = blockIdx.x >> 3, n_idle = late_n_idle();
    if (n_idle > 0 && j >= 17) {
      const int rank = (blockIdx.x & 7) * (nper - 17) + (j - 17), n_early = late_n_early();
      for (int t = rank; t < n_early; t += n_idle) cvt_late_tile(p, t, (float*)smem);
    }
  }
}

template <int HW>
DI void pooled_one(const bf16_t* __restrict__ P, bf16_t* __restrict__ PO, int row, int c8) {
  const int t = row & 4095, base = row - t;
  u32x4 v[2 * HW];
#pragma unroll
  for (int k = 0; k < 2 * HW; ++k) {
    const int sc = min(max(t - HW + k, 0), S - 1);
    v[k] = *(const u32x4*)(P + (size_t)(base + sc) * 512 + c8);
  }
  float acc[8] = {0.f, 0.f, 0.f, 0.f, 0.f, 0.f, 0.f, 0.f};
#pragma unroll
  for (int k = 0; k < 2 * HW; ++k) {
    const int sr = t - HW + k;
    const float w = (sr >= 0 && sr < S) ? 1.f : 0.f;
    acc[0] += w * bflo(v[k].x); acc[1] += w * bfhi(v[k].x); acc[2] += w * bflo(v[k].y); acc[3] += w * bfhi(v[k].y);
    acc[4] += w * bflo(v[k].z); acc[5] += w * bfhi(v[k].z); acc[6] += w * bflo(v[k].w); acc[7] += w * bfhi(v[k].w);
  }
  const float rc = 1.f / (float)(min(t + HW, S) - max(t - HW, 0));
  const u32x4 sv = v[HW];
  float o[8] = {acc[0] * rc - bflo(sv.x), acc[1] * rc - bfhi(sv.x), acc[2] * rc - bflo(sv.y), acc[3] * rc - bfhi(sv.y),
                acc[4] * rc - bflo(sv.z), acc[5] * rc - bfhi(sv.z), acc[6] * rc - bflo(sv.w), acc[7] * rc - bfhi(sv.w)};
  *(uint4*)(PO + (size_t)row * 512 + c8) = pack8(o);
}
DI void phase_pooled(const Params& p) {
  const bf16_t* P = (const bf16_t*)(p.ws + OFF_P);
  bf16_t* PO = (bf16_t*)(p.ws + OFF_POOLED);
  const int total = NTOK * 64;
  for (int i = blockIdx.x * 256 + threadIdx.x; i < total; i += gridDim.x * 256) {
    const int lane = i & 63, wq = i >> 6, g = wq & 3, row = (wq >> 2) * 4 + (lane >> 4), c8 = g * 128 + (lane & 15) * 8;
    if (g == 0) pooled_one<1>(P, PO, row, c8);
    else if (g == 1) pooled_one<2>(P, PO, row, c8);
    else if (g == 2) pooled_one<4>(P, PO, row, c8);
    else pooled_one<8>(P, PO, row, c8);
  }
}

constexpr int AK_ST = 144, AV_ST = 136;
constexpr int ABUF = 64 * AK_ST + 64 * AV_ST;

constexpr int CVT_R0 = 36864, CVT_RSZ = 16384;
DI int late_tile_of(int i) { const int t = late_n_early() + (int)blockIdx.x + i * (int)gridDim.x; return (t < N_LATE) ? t : -1; }
DI void cvt_dma_issue(const Params& p, int t, unsigned char* reg, int tid) {
  const CvtDesc d = cvt_late_desc(p, t);
  const int lane = tid & 63, wave = tid >> 6;
#pragma unroll
  for (int i = 0; i < 4; ++i) {
    const int k = (i * 4 + wave) * 4 + (lane >> 4), pos = lane & 15;
    const float* g = d.src + (size_t)(d.k0 + k) * d.N + d.n0 + ((pos ^ ((k >> 3) & 7)) << 2);
    __builtin_amdgcn_global_load_lds((const unsigned*)g, (unsigned*)(reg + (i * 4 + wave) * 1024), 16, 0, 2);
  }
}
DI void cvt_lds_store(const Params& p, int t, const unsigned char* reg, int tid) {
  const CvtDesc d = cvt_late_desc(p, t);
  const float* R = (const float*)reg;
#pragma unroll
  for (int i = 0; i < 2; ++i) {
    const int c = tid + 256 * i, n = c >> 3, kc = c & 7;
    float v[8];
#pragma unroll
    for (int jj = 0; jj < 8; ++jj) v[jj] = R[(kc * 8 + jj) * 64 + ((((n >> 2) ^ kc) & 15) << 2) + (n & 3)];
    const uint4 o4 = pack8(v);
    __builtin_nontemporal_store((u32x4){o4.x, o4.y, o4.z, o4.w}, (u32x4*)(d.dst + (size_t)(d.n0 + n) * d.K + d.k0 + kc * 8));
  }
}

DI void attn_item(const Params& p, int item, unsigned char* smem, int cvt_i0, int cvt_n) {
  int tid_ = threadIdx.x;
  asm volatile("" : "+v"(tid_));
  const int tid = tid_, lane = tid & 63, wave = tid >> 6, ql = lane & 31, h = lane >> 5;
  const int qb = item & 15, head = (item >> 4) & 7, b = item >> 7, kvh = head >> 2;
  const int tok0 = b * S + qb * 256 + wave * 64 + ql;
  bf16x8 qf[2][4];
#pragma unroll
  for (int g = 0; g < 2; ++g) {
    const bf16_t* Qp = (const bf16_t*)(p.ws + OFF_Q) + (size_t)(tok0 + g * 32) * 512 + head * 64;
#pragma unroll
    for (int s = 0; s < 4; ++s) qf[g][s] = *(const bf16x8*)(Qp + s * 16 + h * 8);
  }
  const bf16_t* Kg = (const bf16_t*)(p.ws + OFF_K) + (size_t)(b * 2 + kvh) * NKEY * 64;
  const bf16_t* Vg = (const bf16_t*)(p.ws + OFF_VT) + (size_t)(b * 2 + kvh) * 64 * NKEY;
  const int lr = tid >> 3, kc = tid & 7;
  const bf16_t* kp = Kg + (size_t)lr * 64 + kc * 8;
  const bf16_t* vp = Vg + (size_t)lr * NKEY + kc * 8;
  u32x4 rk0 = *(const u32x4*)kp, rk1 = *(const u32x4*)(kp + 32 * 64);
  u32x4 rv0 = *(const u32x4*)vp, rv1 = *(const u32x4*)(vp + (size_t)32 * NKEY);
  const int wko = lr * AK_ST + kc * 16, wvo = 64 * AK_ST + lr * AV_ST + kc * 16;
  __syncthreads();
  {
    unsigned char* wk = smem + wko; unsigned char* wv = smem + wvo;
    *(u32x4*)wk = rk0; *(u32x4*)(wk + 32 * AK_ST) = rk1;
    *(u32x2*)wv = rv0.xy; *(u32x2*)(wv + 8) = rv0.zw; *(u32x2*)(wv + 32 * AV_ST) = rv1.xy; *(u32x2*)(wv + 32 * AV_ST + 8) = rv1.zw;
  }
  __syncthreads();
  f32x16 o[2][2];
#pragma unroll
  for (int r = 0; r < 16; ++r) { o[0][0][r] = 0.f; o[0][1][r] = 0.f; o[1][0][r] = 0.f; o[1][1][r] = 0.f; }
  float m_old[2] = {-1e30f, -1e30f}, lsum[2] = {0.f, 0.f};
  constexpr int NT = NKEY / 64;
  for (int j = 0; j < NT; ++j) {
    const unsigned char* sK = smem + (j & 1) * ABUF;
    const unsigned char* sV = sK + 64 * AK_ST;
    int tid2 = tid;
    asm volatile("" : "+v"(tid2));
    if (j < cvt_n) { const int t = late_tile_of(cvt_i0 + j); if (t >= 0) cvt_dma_issue(p, t, smem + CVT_R0 + (j & 1) * CVT_RSZ, tid2); }
    if (j >= 1 && j <= cvt_n) { const int t = late_tile_of(cvt_i0 + j - 1); if (t >= 0) cvt_lds_store(p, t, smem + CVT_R0 + ((j - 1) & 1) * CVT_RSZ, tid2); }
    __builtin_amdgcn_sched_barrier(0);
    if (j + 1 < NT) {
      const int key0 = (j + 1) * 64;
      rk0 = *(const u32x4*)(kp + (size_t)key0 * 64); rk1 = *(const u32x4*)(kp + (size_t)(key0 + 32) * 64);
      rv0 = *(const u32x4*)(vp + key0); rv1 = *(const u32x4*)(vp + (size_t)32 * NKEY + key0);
    }
    f32x16 st[2][2];
#pragma unroll
    for (int g = 0; g < 2; ++g)
#pragma unroll
      for (int kt = 0; kt < 2; ++kt)
#pragma unroll
        for (int r = 0; r < 16; ++r) st[g][kt][r] = 0.f;
#pragma unroll
    for (int kt = 0; kt < 2; ++kt)
#pragma unroll
      for (int s = 0; s < 4; ++s) {
        const bf16x8 kf = *(const bf16x8*)(sK + (kt * 32 + ql) * AK_ST + s * 32 + h * 16);
        st[0][kt] = MFMA32(kf, qf[0][s], st[0][kt]);
        st[1][kt] = MFMA32(kf, qf[1][s], st[1][kt]);
      }
#pragma unroll
    for (int g = 0; g < 2; ++g) {
      float mx = st[g][0][0];
#pragma unroll
      for (int r = 0; r < 16; ++r) { mx = fmaxf(mx, st[g][0][r]); mx = fmaxf(mx, st[g][1][r]); }
      mx = fmaxf(mx, __shfl_xor(mx, 32));
      const float m_new = fmaxf(m_old[g], mx);
      if (__any(m_new > m_old[g])) {
        const float alpha = __builtin_amdgcn_exp2f(m_old[g] - m_new);
        m_old[g] = m_new;
        o[g][0] = o[g][0] * alpha; o[g][1] = o[g][1] * alpha; lsum[g] *= alpha;
      }
      st[g][0] = st[g][0] - m_old[g]; st[g][1] = st[g][1] - m_old[g];
#pragma unroll
      for (int kt = 0; kt < 2; ++kt)
#pragma unroll
        for (int r = 0; r < 16; ++r) { st[g][kt][r] = __builtin_amdgcn_exp2f(st[g][kt][r]); lsum[g] += st[g][kt][r]; }
    }
#pragma unroll
    for (int kt = 0; kt < 2; ++kt)
#pragma unroll
      for (int s2 = 0; s2 < 2; ++s2) {
        bf16x8 pf[2];
#pragma unroll
        for (int g = 0; g < 2; ++g) {
          uint4 pk = make_uint4(pack2(st[g][kt][8 * s2 + 0], st[g][kt][8 * s2 + 1]), pack2(st[g][kt][8 * s2 + 2], st[g][kt][8 * s2 + 3]),
                                pack2(st[g][kt][8 * s2 + 4], st[g][kt][8 * s2 + 5]), pack2(st[g][kt][8 * s2 + 6], st[g][kt][8 * s2 + 7]));
          pf[g] = __builtin_bit_cast(bf16x8, pk);
        }
#pragma unroll
        for (int dt = 0; dt < 2; ++dt) {
          const unsigned char* va = sV + (dt * 32 + ql) * AV_ST + (kt * 32 + 16 * s2 + 4 * h) * 2;
          const uint2 lo = *(const uint2*)va, hi = *(const uint2*)(va + 16);
          const uint4 vv = make_uint4(lo.x, lo.y, hi.x, hi.y);
          const bf16x8 vf = __builtin_bit_cast(bf16x8, vv);
          o[0][dt] = MFMA32(vf, pf[0], o[0][dt]);
          o[1][dt] = MFMA32(vf, pf[1], o[1][dt]);
        }
      }
    if (j + 1 < NT) {
      unsigned char* wk = smem + ((j + 1) & 1) * ABUF + wko; unsigned char* wv = smem + ((j + 1) & 1) * ABUF + wvo;
      *(u32x4*)wk = rk0; *(u32x4*)(wk + 32 * AK_ST) = rk1;
      *(u32x2*)wv = rv0.xy; *(u32x2*)(wv + 8) = rv0.zw; *(u32x2*)(wv + 32 * AV_ST) = rv1.xy; *(u32x2*)(wv + 32 * AV_ST + 8) = rv1.zw;
    }
    asm volatile("s_waitcnt vmcnt(0)" ::: "memory");
    __syncthreads();
  }
  int tokl = b * S + qb * 256 + wave * 64 + ql;
  asm volatile("" : "+v"(tokl));
#pragma unroll
  for (int g = 0; g < 2; ++g) {
    const float lt = lsum[g] + __shfl_xor(lsum[g], 32);
    const float il = 1.f / lt;
    bf16_t* Op = (bf16_t*)(p.ws + OFF_CAT) + (size_t)(tokl + g * 32) * 1024 + head * 64;
#pragma unroll
    for (int dt = 0; dt < 2; ++dt)
#pragma unroll
      for (int q4 = 0; q4 < 4; ++q4) {
        const uint2 w2 = make_uint2(pack2(o[g][dt][4 * q4] * il, o[g][dt][4 * q4 + 1] * il), pack2(o[g][dt][4 * q4 + 2] * il, o[g][dt][4 * q4 + 3] * il));
        *(uint2*)(Op + dt * 32 + 8 * q4 + 4 * h) = w2;
      }
  }
}

DI void phase_attn_pool(const Params& p, unsigned char* smem) {
  constexpr int N_ATT = NB_ * 8 * 16, N_POOL = 64 * 4;
  const int x = blockIdx.x & 7, j = blockIdx.x >> 3, nper = gridDim.x >> 3;
  const int n_i = (N_LATE - late_n_early() + gridDim.x - 1) / gridDim.x;
  float* sm = (float*)smem;
  int done = 0;
  for (int k = j; k < N_ATT / 8; k += nper) {
    const int take = min(n_i - done, 67);
    attn_item(p, (x >> 1) * 128 + ((x & 1) * 4 + (k >> 4)) * 16 + (k & 15), smem, done, take);
    done += take;
  }
  cvt_late_range(p, done, n_i, sm);
  int tidl = threadIdx.x;
  asm volatile("" : "+v"(tidl));
  const int lrow = tidl >> 2;
  for (int k = j; k < N_POOL / 8; k += nper) {
    const int t = k * 8 + x, rt = t >> 2, g = t & 3;
    {
      const bf16_t* P = (const bf16_t*)(p.ws + OFF_P);
      bf16_t* PO = (bf16_t*)(p.ws + OFF_POOLED);
#pragma unroll 1
      for (int i = 0; i < 16; ++i) {
        const int idx = tidl + 256 * i, row = rt * 256 + (idx >> 4), c8 = g * 128 + (idx & 15) * 8;
        if (g == 0) pooled_one<1>(P, PO, row, c8);
        else if (g == 1) pooled_one<2>(P, PO, row, c8);
        else if (g == 2) pooled_one<4>(P, PO, row, c8);
        else pooled_one<8>(P, PO, row, c8);
      }
      asm volatile("s_waitcnt vmcnt(0)" ::: "memory");
      __syncthreads();
    }
    unsigned a_off[4];
#pragma unroll
    for (int i = 0; i < 4; ++i) a_off[i] = (unsigned)(rt * 256 + lrow + 64 * i) * 512 + g * 128;
    const bf16_t* B = (const bf16_t*)(p.ws + OFF_WT_POOL) + g * 16384;
    EpiStore e; e.dst = (bf16_t*)(p.ws + OFF_CAT) + (size_t)rt * 256 * 1024 + 512 + g * 128; e.ld = 1024;
    e.colscale = p.pool_scale + g * 128; e.rowscale = nullptr; e.cmode = 0;
    gemm_tile((const bf16_t*)(p.ws + OFF_POOLED), a_off, B, B + 64 * 128, 128, 128, smem, e);
  }
}

DI void phase_gemm_plain(const bf16_t* A, const bf16_t* Wt, bf16_t* dst, int ncol_tiles, int ldd, unsigned char* smem) {
  const int lrow = threadIdx.x >> 2;
  XCD_LOOP(k, 8 * ncol_tiles) {
    const int rt = 8 * x + k / ncol_tiles, ct = k % ncol_tiles;
    unsigned a_off[4];
#pragma unroll
    for (int i = 0; i < 4; ++i) a_off[i] = (unsigned)(rt * 256 + lrow + 64 * i) * D;
    const bf16_t* B = Wt + (size_t)ct * 128 * D;
    EpiStore e; e.dst = dst + (size_t)rt * 256 * ldd + ct * 128; e.ld = ldd; e.colscale = nullptr; e.rowscale = nullptr; e.cmode = 0;
    gemm_tile(A, a_off, B, B + (size_t)64 * D, D, D, smem, e);
  }
}

DI void phase_ln_mix(const Params& p, int l, unsigned char* smem) {
  const int tid = threadIdx.x, lane = tid & 63, wave = tid >> 6;
  float* wrT = (float*)smem;
  __syncthreads();
  {
    const float* wr = p.w_router + (size_t)l * D * NE;
    for (int i = tid; i < D * NE / 4; i += 256) {
      const float4 v = *(const float4*)(wr + i * 4);
      const int c = i >> 2, e0 = (i & 3) * 4;
      wrT[(e0 + 0) * 1024 + c] = v.x; wrT[(e0 + 1) * 1024 + c] = v.y; wrT[(e0 + 2) * 1024 + c] = v.z; wrT[(e0 + 3) * 1024 + c] = v.w;
    }
  }
  __syncthreads();
  const float* hin = (l == 0) ? p.x : p.out;
  float* hout = (float*)(p.ws + OFF_H1);
  const bf16_t* Y = (const bf16_t*)(p.ws + OFF_Y);
  bf16_t* U = (bf16_t*)(p.ws + OFF_UA);
  float* aff = (float*)(p.ws + OFF_AFF);
  const float* modv = (const float*)(p.ws + OFF_MOD);
  const float* lg = p.ln_mix_g + l * D;
  const float* lb = p.ln_mix_b + l * D;
  const int r0 = (int)(((long long)blockIdx.x * NTOK) / gridDim.x), r1 = (int)(((long long)(blockIdx.x + 1) * NTOK) / gridDim.x);
  const int stride = 4;
  int row = r0 + wave;
  f32x4 LG[4], LB[4], GT[4], SH[4], SC[4];
#pragma unroll
  for (int i = 0; i < 4; ++i) { LG[i] = *(const f32x4*)(lg + lane * 4 + 256 * i); LB[i] = *(const f32x4*)(lb + lane * 4 + 256 * i); }
  int cur_b = -1;
  float4 hv0, hv1, hv2, hv3; u32x2 yv0, yv1, yv2, yv3;
  if (row < r1) {
    const float* hp = hin + (size_t)row * D + lane * 4; const bf16_t* yp = Y + (size_t)row * D + lane * 4;
    { const f32x4 t0_ = __builtin_nontemporal_load((const f32x4*)hp), t1_ = __builtin_nontemporal_load((const f32x4*)(hp + 256)), t2_ = __builtin_nontemporal_load((const f32x4*)(hp + 512)), t3_ = __builtin_nontemporal_load((const f32x4*)(hp + 768));
      hv0 = make_float4(t0_.x, t0_.y, t0_.z, t0_.w); hv1 = make_float4(t1_.x, t1_.y, t1_.z, t1_.w); hv2 = make_float4(t2_.x, t2_.y, t2_.z, t2_.w); hv3 = make_float4(t3_.x, t3_.y, t3_.z, t3_.w); }
    yv0 = *(const u32x2*)yp; yv1 = *(const u32x2*)(yp + 256); yv2 = *(const u32x2*)(yp + 512); yv3 = *(const u32x2*)(yp + 768);
  }
  for (; row < r1; row += stride) {
    const int b = row >> 12, t = row & 4095;
    if (b != cur_b) {
      const float* mb = modv + (size_t)(l * 5 + b) * 6144 + lane * 4;
#pragma unroll
      for (int i = 0; i < 4; ++i) { GT[i] = *(const f32x4*)(mb + 2 * 1024 + 256 * i); SH[i] = *(const f32x4*)(mb + 3 * 1024 + 256 * i); SC[i] = *(const f32x4*)(mb + 4 * 1024 + 256 * i); }
      cur_b = b;
    }
    const float4 ch[4] = {hv0, hv1, hv2, hv3};
    const u32x2 cy[4] = {yv0, yv1, yv2, yv3};
    {
      const int nrow = row + stride;
      if (nrow < r1) {
        const float* hp = hin + (size_t)nrow * D + lane * 4; const bf16_t* yp = Y + (size_t)nrow * D + lane * 4;
        { const f32x4 t0_ = __builtin_nontemporal_load((const f32x4*)hp), t1_ = __builtin_nontemporal_load((const f32x4*)(hp + 256)), t2_ = __builtin_nontemporal_load((const f32x4*)(hp + 512)), t3_ = __builtin_nontemporal_load((const f32x4*)(hp + 768));
      hv0 = make_float4(t0_.x, t0_.y, t0_.z, t0_.w); hv1 = make_float4(t1_.x, t1_.y, t1_.z, t1_.w); hv2 = make_float4(t2_.x, t2_.y, t2_.z, t2_.w); hv3 = make_float4(t3_.x, t3_.y, t3_.z, t3_.w); }
        yv0 = *(const u32x2*)yp; yv1 = *(const u32x2*)(yp + 256); yv2 = *(const u32x2*)(yp + 512); yv3 = *(const u32x2*)(yp + 768);
      }
    }
    float v[16];
    float sum = 0.f;
#pragma unroll
    for (int i = 0; i < 4; ++i) {
      const int c = lane * 4 + 256 * i;
      const f32x4 gt = GT[i];
      v[4 * i + 0] = ALPHA * ch[i].x + gt.x * bflo(cy[i].x); v[4 * i + 1] = ALPHA * ch[i].y + gt.y * bfhi(cy[i].x);
      v[4 * i + 2] = ALPHA * ch[i].z + gt.z * bflo(cy[i].y); v[4 * i + 3] = ALPHA * ch[i].w + gt.w * bfhi(cy[i].y);
      sum += v[4 * i] + v[4 * i + 1] + v[4 * i + 2] + v[4 * i + 3];
    }
    const float mean = wave_sum(sum) * (1.f / 1024.f);
    float sq = 0.f;
#pragma unroll
    for (int j = 0; j < 16; ++j) { v[j] -= mean; sq += v[j] * v[j]; }
    const float rstd = rsqrtf(wave_sum(sq) * (1.f / 1024.f) + LN_EPS);
#pragma unroll
    for (int i = 0; i < 4; ++i) {
      const int c = lane * 4 + 256 * i;
      const f32x4 g4 = LG[i], b4 = LB[i];
      float4 hn;
      hn.x = v[4 * i] * rstd * g4.x + b4.x; hn.y = v[4 * i + 1] * rstd * g4.y + b4.y;
      hn.z = v[4 * i + 2] * rstd * g4.z + b4.z; hn.w = v[4 * i + 3] * rstd * g4.w + b4.w;
      __builtin_nontemporal_store((f32x4){hn.x, hn.y, hn.z, hn.w}, (f32x4*)(hout + (size_t)row * D + c));
      const f32x4 sh = SH[i], sc4 = SC[i];
      v[4 * i] = hn.x * (1.f + sc4.x) + sh.x; v[4 * i + 1] = hn.y * (1.f + sc4.y) + sh.y;
      v[4 * i + 2] = hn.z * (1.f + sc4.z) + sh.z; v[4 * i + 3] = hn.w * (1.f + sc4.w) + sh.w;
      *(uint2*)(U + (size_t)row * D + c) = make_uint2(pack2(v[4 * i], v[4 * i + 1]), pack2(v[4 * i + 2], v[4 * i + 3]));
    }
    float a[16];
#pragma unroll
    for (int e = 0; e < 16; ++e) {
      float acc = 0.f;
#pragma unroll
      for (int i = 0; i < 4; ++i) {
        const float4 w4 = *(const float4*)(wrT + e * 1024 + lane * 4 + 256 * i);
        acc += v[4 * i] * w4.x + v[4 * i + 1] * w4.y + v[4 * i + 2] * w4.z + v[4 * i + 3] * w4.w;
      }
      a[e] = acc;
      if ((e & 3) == 3) asm volatile("" ::: "memory");
    }
    const bool b5 = (lane & 32) != 0, b4_ = (lane & 16) != 0, b3 = (lane & 8) != 0, b2 = (lane & 4) != 0;
    float r8[8], r4[4], r2[2];
#pragma unroll
    for (int i = 0; i < 8; ++i) { const float snd = b5 ? a[i] : a[i + 8]; const float kp = b5 ? a[i + 8] : a[i]; r8[i] = kp + __shfl_xor(snd, 32); }
#pragma unroll
    for (int i = 0; i < 4; ++i) { const float snd = b4_ ? r8[i] : r8[i + 4]; const float kp = b4_ ? r8[i + 4] : r8[i]; r4[i] = kp + __shfl_xor(snd, 16); }
#pragma unroll
    for (int i = 0; i < 2; ++i) { const float snd = b3 ? r4[i] : r4[i + 2]; const float kp = b3 ? r4[i + 2] : r4[i]; r2[i] = kp + __shfl_xor(snd, 8); }
    float lgt;
    { const float snd = b2 ? r2[0] : r2[1]; const float kp = b2 ? r2[1] : r2[0]; lgt = kp + __shfl_xor(snd, 4); }
    lgt += __shfl_xor(lgt, 2); lgt += __shfl_xor(lgt, 1);
    float mx = lgt;
    mx = fmaxf(mx, __shfl_xor(mx, 4)); mx = fmaxf(mx, __shfl_xor(mx, 8)); mx = fmaxf(mx, __shfl_xor(mx, 16)); mx = fmaxf(mx, __shfl_xor(mx, 32));
    const float ex = expf(lgt - mx);
    float se = ex;
    se += __shfl_xor(se, 4); se += __shfl_xor(se, 8); se += __shfl_xor(se, 16); se += __shfl_xor(se, 32);
    if ((lane & 3) == 0) aff[(size_t)(b * 16 + ((lane >> 2) & 15)) * S + t] = ex / se;
  }
}

DI void phase_topk(const Params& p, unsigned char* smem) {
  const int tid = threadIdx.x, lane = tid & 63, wave = tid >> 6;
  unsigned* hist = (unsigned*)smem;
  unsigned* wtot = hist + 256;
  const float* aff = (const float*)(p.ws + OFF_AFF);
  int* idx = (int*)(p.ws + OFF_IDX);
  float* gatev = (float*)(p.ws + OFF_GATEV);
  int* inv = (int*)(p.ws + OFF_INV);
  for (int be = blockIdx.x; be < NB_ * NE; be += gridDim.x) {
    const int b = be >> 4, e = be & 15;
    unsigned v[16];
#pragma unroll
    for (int i = 0; i < 4; ++i) {
      const float4 f = *(const float4*)(aff + (size_t)be * S + tid * 16 + i * 4);
      v[4 * i] = __float_as_uint(f.x); v[4 * i + 1] = __float_as_uint(f.y); v[4 * i + 2] = __float_as_uint(f.z); v[4 * i + 3] = __float_as_uint(f.w);
    }
    unsigned prefix = 0, mask = 0; int need = CAP;
#pragma unroll 1
    for (int pass = 0; pass < 4; ++pass) {
      const int shift = 24 - 8 * pass;
      __syncthreads();
      hist[tid] = 0;
      __syncthreads();
#pragma unroll
      for (int j = 0; j < 16; ++j) if ((v[j] & mask) == prefix) atomicAdd(&hist[(v[j] >> shift) & 255], 1u);
      __syncthreads();
      {
        const int hcount = (int)hist[tid];
        int sfx = hcount;
#pragma unroll
        for (int o = 1; o < 64; o <<= 1) { const int n = __shfl_down(sfx, o); if (lane + o < 64) sfx += n; }
        if (lane == 0) wtot[wave] = (unsigned)sfx;
        __syncthreads();
        for (int w = wave + 1; w < 4; ++w) sfx += (int)wtot[w];
        if (sfx >= need && sfx - hcount < need) { wtot[4] = (unsigned)tid; wtot[5] = (unsigned)(sfx - hcount); }
        __syncthreads();
        const int bin = (int)wtot[4];
        need -= (int)wtot[5];
        prefix |= (unsigned)bin << shift; mask |= 255u << shift;
      }
    }
    const unsigned T = prefix;
    int cg_ = 0, ce_ = 0;
#pragma unroll
    for (int j = 0; j < 16; ++j) { cg_ += (v[j] > T); ce_ += (v[j] == T); }
    int packed = cg_ | (ce_ << 16);
    int incl = packed;
#pragma unroll
    for (int o = 1; o < 64; o <<= 1) { const int n = __shfl_up(incl, o); if (lane >= o) incl += n; }
    __syncthreads();
    if (lane == 63) wtot[wave] = (unsigned)incl;
    __syncthreads();
    int base = incl - packed;
    for (int w = 0; w < wave; ++w) base += (int)wtot[w];
    int bg = base & 0xffff, beq = base >> 16;
    const int ngt = CAP - need;
#pragma unroll
    for (int j = 0; j < 16; ++j) {
      const int t = tid * 16 + j;
      int slot = -1;
      if (v[j] > T) { slot = bg; ++bg; }
      else if (v[j] == T) { if (beq < need) slot = ngt + beq; ++beq; }
      if (slot >= 0) { idx[be * CAP + slot] = t; gatev[be * CAP + slot] = __uint_as_float(v[j]); }
      inv[(size_t)(b * S + t) * NE + e] = slot;
    }
  }
}

DI void phase_moe_up(const Params& p, int l, unsigned char* smem) {
  const int lrow = threadIdx.x >> 2;
  const int* idx = (const int*)(p.ws + OFF_IDX);
  const bf16_t* U = (const bf16_t*)(p.ws + OFF_UA);
  bf16_t* act = (bf16_t*)(p.ws + OFF_ACT);
  XCD_LOOP(k, 256) {
    const int e = 4 * (k >> 6) + (x >> 1), m = k & 7, ct = (x & 1) * 8 + ((k >> 3) & 7);
    const int b = m >> 1, rt = m & 1, be = b * 16 + e;
    unsigned a_off[4];
#pragma unroll
    for (int i = 0; i < 4; ++i) a_off[i] = (unsigned)(b * S + idx[be * CAP + rt * 256 + lrow + 64 * i]) * D;
    const size_t wo = ((size_t)(l * 16 + e) * 1024 + ct * 64) * 1024;
    EpiStore ep; ep.dst = act + ((size_t)be * CAP + rt * 256) * FF + ct * 64; ep.ld = FF; ep.colscale = nullptr; ep.rowscale = nullptr; ep.cmode = 1;
    gemm_tile(U, a_off, (const bf16_t*)(p.ws + OFF_WT_G) + wo, (const bf16_t*)(p.ws + OFF_WT_U) + wo, D, D, smem, ep);
  }
}
DI void phase_moe_down(const Params& p, int l, unsigned char* smem) {
  const int lrow = threadIdx.x >> 2;
  const bf16_t* act = (const bf16_t*)(p.ws + OFF_ACT);
  bf16_t* Y2 = (bf16_t*)(p.ws + OFF_Y2);
  const float* gatev = (const float*)(p.ws + OFF_GATEV);
  XCD_LOOP(k, 128) {
    const int e = 8 * (k >> 6) + x, m = k & 7, ct = (k >> 3) & 7;
    const int b = m >> 1, rt = m & 1, be = b * 16 + e;
    unsigned a_off[4];
#pragma unroll
    for (int i = 0; i < 4; ++i) a_off[i] = (unsigned)(be * CAP + rt * 256 + lrow + 64 * i) * FF;
    const bf16_t* B = (const bf16_t*)(p.ws + OFF_WT_D) + ((size_t)(l * 16 + e) * 1024 + ct * 128) * 1024;
    EpiStore ep; ep.dst = Y2 + ((size_t)be * CAP + rt * 256) * D + ct * 128; ep.ld = D; ep.colscale = nullptr;
    ep.rowscale = gatev + be * CAP + rt * 256; ep.cmode = 0;
    gemm_tile(act, a_off, B, B + (size_t)64 * FF, FF, FF, smem, ep);
  }
}

DI void phase_ln_ffn(const Params& p, int l) {
  const int tid = threadIdx.x, lane = tid & 63, wave = tid >> 6;
  const float* hin = (const float*)(p.ws + OFF_H1);
  float* hout = p.out;
  const bf16_t* Y2 = (const bf16_t*)(p.ws + OFF_Y2);
  const int* inv = (const int*)(p.ws + OFF_INV);
  bf16_t* U = (bf16_t*)(p.ws + OFF_UB);
  const float* modv = (const float*)(p.ws + OFF_MOD);
  const float* lg = p.ln_ffn_g + l * D;
  const float* lb = p.ln_ffn_b + l * D;
  const int r0 = (int)(((long long)blockIdx.x * NTOK) / gridDim.x), r1 = (int)(((long long)(blockIdx.x + 1) * NTOK) / gridDim.x);
  const int stride = 4;
  int row = r0 + wave;
  f32x4 LG[4], LB[4], GT[4], SH[4], SC[4];
#pragma unroll
  for (int i = 0; i < 4; ++i) { LG[i] = *(const f32x4*)(lg + lane * 4 + 256 * i); LB[i] = *(const f32x4*)(lb + lane * 4 + 256 * i); SH[i] = LG[i]; SC[i] = LG[i]; }
  int cur_b = -1;
  float4 hv0, hv1, hv2, hv3; int nslot = -1;
  if (row < r1) {
    const float* hp = hin + (size_t)row * D + lane * 4;
    { const f32x4 t0_ = __builtin_nontemporal_load((const f32x4*)hp), t1_ = __builtin_nontemporal_load((const f32x4*)(hp + 256)), t2_ = __builtin_nontemporal_load((const f32x4*)(hp + 512)), t3_ = __builtin_nontemporal_load((const f32x4*)(hp + 768));
      hv0 = make_float4(t0_.x, t0_.y, t0_.z, t0_.w); hv1 = make_float4(t1_.x, t1_.y, t1_.z, t1_.w); hv2 = make_float4(t2_.x, t2_.y, t2_.z, t2_.w); hv3 = make_float4(t3_.x, t3_.y, t3_.z, t3_.w); }
    nslot = (lane < 16) ? inv[(size_t)row * NE + lane] : -1;
  }
  for (; row < r1; row += stride) {
    const int b = row >> 12;
    if (b != cur_b) {
      const float* mb = modv + (size_t)(l * 5 + b) * 6144 + lane * 4;
      const float* mn = modv + (size_t)(5 + b) * 6144 + lane * 4;
#pragma unroll
      for (int i = 0; i < 4; ++i) {
        GT[i] = *(const f32x4*)(mb + 5 * 1024 + 256 * i);
        if (l == 0) { SH[i] = *(const f32x4*)(mn + 256 * i); SC[i] = *(const f32x4*)(mn + 1024 + 256 * i); }
      }
      cur_b = b;
    }
    const float4 ch[4] = {hv0, hv1, hv2, hv3};
    const int myslot = nslot;
    {
      const int nrow = row + stride;
      if (nrow < r1) {
        const float* hp = hin + (size_t)nrow * D + lane * 4;
        { const f32x4 t0_ = __builtin_nontemporal_load((const f32x4*)hp), t1_ = __builtin_nontemporal_load((const f32x4*)(hp + 256)), t2_ = __builtin_nontemporal_load((const f32x4*)(hp + 512)), t3_ = __builtin_nontemporal_load((const f32x4*)(hp + 768));
      hv0 = make_float4(t0_.x, t0_.y, t0_.z, t0_.w); hv1 = make_float4(t1_.x, t1_.y, t1_.z, t1_.w); hv2 = make_float4(t2_.x, t2_.y, t2_.z, t2_.w); hv3 = make_float4(t3_.x, t3_.y, t3_.z, t3_.w); }
        nslot = (lane < 16) ? inv[(size_t)nrow * NE + lane] : -1;
      }
    }
    float f[16];
#pragma unroll
    for (int j = 0; j < 16; ++j) f[j] = 0.f;
    unsigned m = (unsigned)__ballot(myslot >= 0);
    const bf16_t* ybase = Y2 + (size_t)b * 16 * CAP * D + lane * 4;
    while (m) {
      int e0 = __ffs(m) - 1; m &= m - 1;
      int e1 = -1, e2 = -1, e3 = -1;
      if (m) { e1 = __ffs(m) - 1; m &= m - 1; }
      if (m) { e2 = __ffs(m) - 1; m &= m - 1; }
      if (m) { e3 = __ffs(m) - 1; m &= m - 1; }
      const int s0 = __shfl(myslot, e0), s1 = __shfl(myslot, e1 < 0 ? 0 : e1), s2 = __shfl(myslot, e2 < 0 ? 0 : e2), s3 = __shfl(myslot, e3 < 0 ? 0 : e3);
      u32x2 y0[4], y1[4], y2[4], y3[4];
#pragma unroll
      for (int i = 0; i < 4; ++i) { y1[i] = (u32x2){0u, 0u}; y2[i] = (u32x2){0u, 0u}; y3[i] = (u32x2){0u, 0u}; }
      {
        const bf16_t* yr = ybase + ((size_t)e0 * CAP + s0) * D;
#pragma unroll
        for (int i = 0; i < 4; ++i) y0[i] = *(const u32x2*)(yr + 256 * i);
      }
      if (e1 >= 0) { const bf16_t* yr = ybase + ((size_t)e1 * CAP + s1) * D;
#pragma unroll
        for (int i = 0; i < 4; ++i) y1[i] = *(const u32x2*)(yr + 256 * i); }
      if (e2 >= 0) { const bf16_t* yr = ybase + ((size_t)e2 * CAP + s2) * D;
#pragma unroll
        for (int i = 0; i < 4; ++i) y2[i] = *(const u32x2*)(yr + 256 * i); }
      if (e3 >= 0) { const bf16_t* yr = ybase + ((size_t)e3 * CAP + s3) * D;
#pragma unroll
        for (int i = 0; i < 4; ++i) y3[i] = *(const u32x2*)(yr + 256 * i); }
#pragma unroll
      for (int i = 0; i < 4; ++i) {
        f[4 * i] += (bflo(y0[i].x) + bflo(y1[i].x)) + (bflo(y2[i].x) + bflo(y3[i].x));
        f[4 * i + 1] += (bfhi(y0[i].x) + bfhi(y1[i].x)) + (bfhi(y2[i].x) + bfhi(y3[i].x));
        f[4 * i + 2] += (bflo(y0[i].y) + bflo(y1[i].y)) + (bflo(y2[i].y) + bflo(y3[i].y));
        f[4 * i + 3] += (bfhi(y0[i].y) + bfhi(y1[i].y)) + (bfhi(y2[i].y) + bfhi(y3[i].y));
      }
    }
    float v[16];
    float sum = 0.f;
#pragma unroll
    for (int i = 0; i < 4; ++i) {
      const int c = lane * 4 + 256 * i;
      const f32x4 gt = GT[i];
      v[4 * i + 0] = ALPHA * ch[i].x + gt.x * f[4 * i]; v[4 * i + 1] = ALPHA * ch[i].y + gt.y * f[4 * i + 1];
      v[4 * i + 2] = ALPHA * ch[i].z + gt.z * f[4 * i + 2]; v[4 * i + 3] = ALPHA * ch[i].w + gt.w * f[4 * i + 3];
      sum += v[4 * i] + v[4 * i + 1] + v[4 * i + 2] + v[4 * i + 3];
    }
    const float mean = wave_sum(sum) * (1.f / 1024.f);
    float sq = 0.f;
#pragma unroll
    for (int j = 0; j < 16; ++j) { v[j] -= mean; sq += v[j] * v[j]; }
    const float rstd = rsqrtf(wave_sum(sq) * (1.f / 1024.f) + LN_EPS);
#pragma unroll
    for (int i = 0; i < 4; ++i) {
      const int c = lane * 4 + 256 * i;
      const f32x4 g4 = LG[i], b4 = LB[i];
      float4 hn;
      hn.x = v[4 * i] * rstd * g4.x + b4.x; hn.y = v[4 * i + 1] * rstd * g4.y + b4.y;
      hn.z = v[4 * i + 2] * rstd * g4.z + b4.z; hn.w = v[4 * i + 3] * rstd * g4.w + b4.w;
      __builtin_nontemporal_store((f32x4){hn.x, hn.y, hn.z, hn.w}, (f32x4*)(hout + (size_t)row * D + c));
      if (l == 0) {
        const f32x4 sh = SH[i], sc4 = SC[i];
        *(uint2*)(U + (size_t)row * D + c) = make_uint2(pack2(hn.x * (1.f + sc4.x) + sh.x, hn.y * (1.f + sc4.y) + sh.y),
                                                        pack2(hn.z * (1.f + sc4.z) + sh.z, hn.w * (1.f + sc4.w) + sh.w));
      }
    }
  }
}

DI void phase_conv_in(const Params& p, unsigned char* smem) {
  const int lrow = threadIdx.x >> 2;
  const bf16_t* U = (const bf16_t*)(p.ws + OFF_UB);
  const bf16_t* Wt = (const bf16_t*)(p.ws + OFF_WT_CIN);
  XCD_LOOP(k, 192) {
    const int rt = 8 * x + k / 24, cc = k % 24;
    unsigned a_off[4];
#pragma unroll
    for (int i = 0; i < 4; ++i) a_off[i] = (unsigned)(rt * 256 + lrow + 64 * i) * D;
    EpiStore ep; ep.ld = D; ep.colscale = nullptr; ep.rowscale = nullptr;
    if (cc < 16) {
      ep.dst = (bf16_t*)(p.ws + OFF_CX) + (size_t)rt * 256 * D + cc * 64; ep.cmode = 2;
      gemm_tile(U, a_off, Wt + (size_t)(1024 + cc * 64) * D, Wt + (size_t)(2048 + cc * 64) * D, D, D, smem, ep);
    } else {
      const int ct = cc - 16;
      ep.dst = (bf16_t*)(p.ws + OFF_BG) + (size_t)rt * 256 * D + ct * 128; ep.cmode = 0;
      const bf16_t* B = Wt + (size_t)(ct * 128) * D;
      gemm_tile(U, a_off, B, B + (size_t)64 * D, D, D, smem, ep);
    }
  }
}
DI void phase_conv_gate(const Params& p) {
  const bf16_t* BG = (const bf16_t*)(p.ws + OFF_BG);
  const bf16_t* CX = (const bf16_t*)(p.ws + OFF_CX);
  bf16_t* Z = (bf16_t*)(p.ws + OFF_Z);
  const int total = NTOK * 128;
  for (int i = blockIdx.x * 256 + threadIdx.x; i < total; i += gridDim.x * 256) {
    const int row = i >> 7, c8 = (i & 127) * 8, t = row & 4095;
    float xm[8], x0[8], xp[8], bg[8], z[8];
    unpack8(*(const uint4*)(CX + (size_t)row * D + c8), x0);
    if (t > 0) unpack8(*(const uint4*)(CX + (size_t)(row - 1) * D + c8), xm);
    else {
#pragma unroll
      for (int j = 0; j < 8; ++j) xm[j] = 0.f; }
    if (t < S - 1) unpack8(*(const uint4*)(CX + (size_t)(row + 1) * D + c8), xp);
    else {
#pragma unroll
      for (int j = 0; j < 8; ++j) xp[j] = 0.f; }
    unpack8(*(const uint4*)(BG + (size_t)row * D + c8), bg);
#pragma unroll
    for (int j = 0; j < 8; ++j)
      z[j] = bg[j] * (p.conv_w[c8 + j] * xm[j] + p.conv_w[1024 + c8 + j] * x0[j] + p.conv_w[2048 + c8 + j] * xp[j]);
    *(uint4*)(Z + (size_t)row * D + c8) = pack8(z);
  }
}

#define XB_TMO      128
#define XB_XCNT(j)  (256  + 64 * (j))
#define XB_XSUB(j)  (1280 + 64 * (j))
#define XB_XGEN(j)  (2304 + 64 * (j))
#define XB_TOP      3328
#define XB_TOPGEN   3392
#define XCD_BAR_WORDS 3456
#define XB_SPIN_CAP (1u << 20)
DI unsigned xb_ld(unsigned* p) { return __hip_atomic_load(p, __ATOMIC_RELAXED, __HIP_MEMORY_SCOPE_AGENT); }
DI unsigned xb_add(unsigned* p, unsigned v) { return __hip_atomic_fetch_add(p, v, __ATOMIC_RELAXED, __HIP_MEMORY_SCOPE_AGENT); }
DI unsigned xb_xcc_id() { return (unsigned)__builtin_amdgcn_s_getreg((3 << 11) | 20) & 0xFu; }
#define XB_SPIN(cond, bar) do { unsigned _sp = 0; while (cond) { __builtin_amdgcn_s_sleep(1); \
    if ((++_sp & 255u) == 0u) { if (xb_ld(&(bar)[XB_TMO])) break; if (_sp > XB_SPIN_CAP) { atomicAdd(&(bar)[XB_TMO], 1u); break; } } } } while (0)
struct XcdBarrier { unsigned* bar; unsigned x; volatile unsigned* st; };
DI XcdBarrier xcd_barrier_post(unsigned* bar, volatile unsigned* st) {
  XcdBarrier b; b.bar = bar; b.x = xb_xcc_id(); b.st = st;
  if (threadIdx.x == 0) (void)xb_add(&bar[XB_XCNT(b.x)], 1u);
  return b;
}
DI void xcd_barrier_complete(unsigned* bar, unsigned x, unsigned& nloc, unsigned& nx) {
  const unsigned G = gridDim.x;
  unsigned sum, cnt, mine, sp = 0u;
  for (;;) {
    sum = 0u; cnt = 0u; mine = 0u;
#pragma unroll
    for (unsigned j = 0; j < 16; ++j) { const unsigned c = xb_ld(&bar[XB_XCNT(j)]); sum += c; cnt += (c > 0u) ? 1u : 0u; mine = (j == x) ? c : mine; }
    if (sum == G) break;
    __builtin_amdgcn_s_sleep(1);
    if ((++sp & 255u) == 0u) { if (xb_ld(&bar[XB_TMO])) break; if (sp > XB_SPIN_CAP) { atomicAdd(&bar[XB_TMO], 1u); break; } }
  }
  nloc = mine > 0u ? mine : 1u; nx = cnt > 0u ? cnt : 1u;
}
DI void xcd_barrier(const XcdBarrier& b) {
  asm volatile("s_waitcnt vmcnt(0)" ::: "memory");
  __syncthreads();
  if (threadIdx.x == 0) {
    unsigned* bar = b.bar;
    __builtin_amdgcn_s_waitcnt(0);
    unsigned nloc = b.st[0], nx = b.st[1];
    if (nloc == 0u) { xcd_barrier_complete(bar, b.x, nloc, nx); b.st[0] = nloc; b.st[1] = nx; }
    const unsigned old = xb_add(&bar[XB_XSUB(b.x)], 1u);
    const unsigned gen = old / nloc;
    if (old + 1u == (gen + 1u) * nloc) {
      __builtin_amdgcn_fence(__ATOMIC_RELEASE, "agent");
      asm volatile("s_waitcnt vmcnt(0)" ::: "memory");
      const unsigned og = xb_add(&bar[XB_TOP], 1u);
      const unsigned tg = og / nx;
      if (og + 1u == (tg + 1u) * nx) xb_add(&bar[XB_TOPGEN], 1u);
      else XB_SPIN(xb_ld(&bar[XB_TOPGEN]) == tg, bar);
      __builtin_amdgcn_fence(__ATOMIC_ACQUIRE, "agent");
      xb_add(&bar[XB_XGEN(b.x)], 1u);
      asm volatile("s_waitcnt vmcnt(0)" ::: "memory");
    } else {
      XB_SPIN(xb_ld(&bar[XB_XGEN(b.x)]) == gen, bar);
      __builtin_amdgcn_fence(__ATOMIC_ACQUIRE, "agent");
      asm volatile("s_waitcnt vmcnt(0)" ::: "memory");
    }
  }
  __syncthreads();
}

__global__ void __launch_bounds__(256, 2) fwd_megakernel(Params p) {
  extern __shared__ __attribute__((aligned(16))) unsigned char smem[];
  cg::grid_group grid = cg::this_grid();
  if (p.ph_lo < 0) grid.sync();
  volatile unsigned* xst = (volatile unsigned*)(smem + LDS_BYTES - 16);
  if (threadIdx.x == 0) { xst[0] = 0u; xst[1] = 0u; }
  __syncthreads();
  XcdBarrier xb = xcd_barrier_post((unsigned*)(p.ws + OFF_BAR), xst);
#ifndef DUPMASK
#define DUPMASK 0u
#endif
#define PH(n, call) if (p.ph_lo <= (n) && (n) < p.ph_hi) { call; if ((DUPMASK >> (n)) & 1u) { xcd_barrier(xb); call; } if ((n) + 1 < p.ph_hi) xcd_barrier(xb); }
  PH(0, phase_prologue(p, smem))
  PH(1, phase_mod_input(p))
  PH(2, phase_inproj(p, smem))
  PH(4, phase_attn_pool(p, smem))
  PH(5, phase_gemm_plain((const bf16_t*)(p.ws + OFF_CAT), (const bf16_t*)(p.ws + OFF_WT_OUT), (bf16_t*)(p.ws + OFF_Y), 8, D, smem))
  PH(6, phase_ln_mix(p, 0, smem))
  PH(7, phase_topk(p, smem))
  PH(8, phase_moe_up(p, 0, smem))
  PH(9, phase_moe_down(p, 0, smem))
  PH(10, phase_ln_ffn(p, 0))
  PH(11, phase_conv_in(p, smem))
  PH(12, phase_conv_gate(p))
  PH(13, phase_gemm_plain((const bf16_t*)(p.ws + OFF_Z), (const bf16_t*)(p.ws + OFF_WT_COUT), (bf16_t*)(p.ws + OFF_Y), 8, D, smem))
  PH(14, phase_ln_mix(p, 1, smem))
  PH(15, phase_topk(p, smem))
  PH(16, phase_moe_up(p, 1, smem))
  PH(17, phase_moe_down(p, 1, smem))
  PH(18, phase_ln_ffn(p, 1))
#undef PH
}

extern "C" void kernel_launch(void* const* d_in, const int* in_sizes, int n_in, void* d_out, int out_size, void* d_ws,
                              size_t ws_size, hipStream_t stream) {
  static int grid_blocks = 0;
  if (!grid_blocks) {
    if (n_in != 23 || ws_size < WS_END) { fprintf(stderr, "kernel_launch: unexpected n_in %d or ws_size %zu (need %zu)\n", n_in, ws_size, (size_t)WS_END); grid_blocks = -1; return; }
    int dev = 0, cus = 0, per_cu = 0;
    hipGetDevice(&dev);
    hipDeviceGetAttribute(&cus, hipDeviceAttributeMultiprocessorCount, dev);
    if (hipFuncSetAttribute((const void*)fwd_megakernel, hipFuncAttributeMaxDynamicSharedMemorySize, LDS_BYTES) != hipSuccess) { fprintf(stderr, "kernel_launch: hipFuncSetAttribute(%d B dynamic LDS) failed\n", LDS_BYTES); grid_blocks = -1; return; }
    hipOccupancyMaxActiveBlocksPerMultiprocessor(&per_cu, fwd_megakernel, 256, LDS_BYTES);
    if (per_cu < 1) per_cu = 1;
    if (per_cu > 2) per_cu = 2;
    grid_blocks = cus * per_cu;
  }
  if (grid_blocks < 0) return;
  Params p{};
  const float** f = (const float**)&p;
  for (int i = 0; i < 23; ++i) f[i] = (const float*)d_in[i];
  p.out = (float*)d_out; p.ws = (unsigned char*)d_ws; p.ph_lo = 0; p.ph_hi = 19;
  (void)hipMemsetAsync((unsigned char*)d_ws + OFF_BAR, 0, 16384, stream);
  void* args[] = {&p};
  hipError_t e = hipLaunchCooperativeKernel((void*)fwd_megakernel, dim3(grid_blocks), dim3(256), args, LDS_BYTES, stream);
  if (e != hipSuccess) fprintf(stderr, "cooperative launch failed: %s (grid %d)\n", hipGetErrorString(e), grid_blocks);
}
```

```cpp
#include <hip/hip_runtime.h>
#include <hip/hip_cooperative_groups.h>
#include <cstdio>
namespace cg = cooperative_groups;

typedef unsigned short bf16_t;
using bf16x8 = __attribute__((ext_vector_type(8))) short;
using f32x16 = __attribute__((ext_vector_type(16))) float;
typedef unsigned u32x4 __attribute__((ext_vector_type(4)));
typedef unsigned u32x2 __attribute__((ext_vector_type(2)));
typedef float f32x4 __attribute__((ext_vector_type(4)));
#define DI __device__ __forceinline__
#define MFMA32(a, b, c) __builtin_amdgcn_mfma_f32_32x32x16_bf16((a), (b), (c), 0, 0, 0)

constexpr int D = 1024, NB_ = 4, S = 4096, NTOK = NB_ * S, CTXL = 256, NCTX = NB_ * CTXL;
constexpr int NKEY = S + CTXL;
constexpr int NE = 16, CAP = 512, FF = 1024;
constexpr float LN_EPS = 1e-6f;
constexpr float QSCALE = 0.125f * 1.4426950408889634f;
constexpr float ALPHA = 1.41421356237309515f;

constexpr size_t MiB = 1ull << 20;
constexpr size_t OFF_WT_IN = 0;
constexpr size_t OFF_WT_OUT = OFF_WT_IN + 1280ull * 1024 * 2;
constexpr size_t OFF_WT_POOL = OFF_WT_OUT + 2 * MiB;
constexpr size_t OFF_WT_CIN = OFF_WT_POOL + 4ull * 128 * 128 * 2;
constexpr size_t OFF_WT_COUT = OFF_WT_CIN + 6 * MiB;
constexpr size_t OFF_WT_G = OFF_WT_COUT + 2 * MiB;
constexpr size_t OFF_WT_U = OFF_WT_G + 64 * MiB;
constexpr size_t OFF_WT_D = OFF_WT_U + 64 * MiB;
constexpr size_t OFF_MOD = OFF_WT_D + 64 * MiB;
constexpr size_t OFF_ROPE = OFF_MOD + 2ull * 5 * 6144 * 4;
constexpr size_t OFF_UCTX = OFF_ROPE + 8192;
constexpr size_t OFF_M = OFF_UCTX + 2 * MiB;
constexpr size_t OFF_Q = OFF_M;
constexpr size_t OFF_K = OFF_M + 16 * MiB;
constexpr size_t OFF_VT = OFF_M + 21 * MiB;
constexpr size_t OFF_P = OFF_M + 26 * MiB;
constexpr size_t OFF_POOLED = OFF_M + 42 * MiB;
constexpr size_t OFF_CAT = OFF_M + 58 * MiB;
constexpr size_t OFF_BG = OFF_M;
constexpr size_t OFF_CX = OFF_M + 32 * MiB;
constexpr size_t OFF_Z = OFF_M + 64 * MiB;
constexpr size_t OFF_ACT = OFF_M;
constexpr size_t OFF_UB = OFF_M + 96 * MiB;
constexpr size_t OFF_Y = OFF_M + 128 * MiB;
constexpr size_t OFF_UA = OFF_Y + 32 * MiB;
constexpr size_t OFF_Y2 = OFF_Y;
constexpr size_t OFF_H1 = OFF_UA + 32 * MiB;
constexpr size_t OFF_AFF = OFF_H1 + 64 * MiB;
constexpr size_t OFF_IDX = OFF_AFF + 1 * MiB;
constexpr size_t OFF_GATEV = OFF_IDX + 128 * 1024;
constexpr size_t OFF_INV = OFF_GATEV + 128 * 1024;
constexpr size_t OFF_BAR = OFF_INV + 1 * MiB;
constexpr size_t WS_END = OFF_BAR + 16384;

struct Params {
  const float *x, *c, *ctx, *c_ctx, *w_mod, *b_mod, *ln_mix_g, *ln_mix_b, *ln_ffn_g, *ln_ffn_b;
  const float *w_mix_in, *q_norm_g, *k_norm_g, *w_pool_grp, *pool_scale, *w_mix_out;
  const float *w_conv_in, *conv_w, *w_conv_out, *w_router, *w_exp_gate, *w_exp_up, *w_exp_down;
  float* out;
  unsigned char* ws;
  int ph_lo, ph_hi;
};

DI unsigned pack2(float a, float b) {
  typedef float f2 __attribute__((ext_vector_type(2)));
  typedef __bf16 b2 __attribute__((ext_vector_type(2)));
  f2 v = {a, b};
  b2 r = __builtin_convertvector(v, b2);
  return __builtin_bit_cast(unsigned, r);
}
DI float bflo(unsigned u) { return __uint_as_float(u << 16); }
DI float bfhi(unsigned u) { return __uint_as_float(u & 0xffff0000u); }
DI uint4 pack8(const float* v) { return make_uint4(pack2(v[0], v[1]), pack2(v[2], v[3]), pack2(v[4], v[5]), pack2(v[6], v[7])); }
DI void unpack8(uint4 u, float* v) {
  v[0] = bflo(u.x); v[1] = bfhi(u.x); v[2] = bflo(u.y); v[3] = bfhi(u.y);
  v[4] = bflo(u.z); v[5] = bfhi(u.z); v[6] = bflo(u.w); v[7] = bfhi(u.w);
}
DI int crow(int reg, int h) { return (reg & 3) + 8 * (reg >> 2) + 4 * h; }
DI float wave_sum(float v) {
#pragma unroll
  for (int o = 32; o >= 1; o >>= 1) v += __shfl_xor(v, o);
  return v;
}

constexpr int GST = 144;
constexpr int EST = 132;
constexpr int LDS_BYTES = 3 * 24576 + 16;

constexpr int GROW = 64;
constexpr int GSTG = 384 * GROW;
#define WAIT_VM(n) asm volatile("s_waitcnt vmcnt(" #n ")" ::: "memory")
#define GLDS16(g, l) __builtin_amdgcn_global_load_lds((const unsigned*)(g), (unsigned*)(l), 16, 0, 0)

template <class Epi>
DI void gemm_tile(const bf16_t* A, const unsigned (&a_off)[4], const bf16_t* B0, const bf16_t* B1, int ldb, int K,
                  unsigned char* smem, const Epi& epi) {
  const int tid = threadIdx.x, lane = tid & 63, wave = tid >> 6;
  const int wm = wave >> 1, wn = wave & 1;
  const int lrow = tid >> 2, kc = tid & 3;
  const int ql = lane & 31, h = lane >> 5;
  f32x16 acc[4][2];
#pragma unroll
  for (int mi = 0; mi < 4; ++mi)
#pragma unroll
    for (int ni = 0; ni < 2; ++ni)
#pragma unroll
      for (int r = 0; r < 16; ++r) acc[mi][ni][r] = 0.f;

  const int csrc = (kc ^ ((lrow >> 2) & 3)) * 8;
  const unsigned char* Ab = (const unsigned char*)A;
  const unsigned char* bp0 = (const unsigned char*)(B0 + (size_t)lrow * ldb + csrc);
  const unsigned char* bp1 = (const unsigned char*)(B1 + (size_t)lrow * ldb + csrc);
  unsigned ao[4];
#pragma unroll
  for (int i = 0; i < 4; ++i) ao[i] = (a_off[i] + csrc) * 2u;
  unsigned char* dbase = smem + wave * 1024;
  const int nk = K >> 5;
  WAIT_VM(0);
  __syncthreads();
  {
#pragma unroll
    for (int i = 0; i < 4; ++i) GLDS16(Ab + ao[i], dbase + i * 4096);
    GLDS16(bp0, dbase + 16384); GLDS16(bp1, dbase + 20480);
    const unsigned kb = (nk > 1) ? 64u : 0u;
#pragma unroll
    for (int i = 0; i < 4; ++i) GLDS16(Ab + ao[i] + kb, dbase + GSTG + i * 4096);
    GLDS16(bp0 + kb, dbase + GSTG + 16384); GLDS16(bp1 + kb, dbase + GSTG + 20480);
  }
  const int sw = (ql >> 2) & 3;
  const int o0 = ((0 + h) ^ sw) * 16, o1 = ((2 + h) ^ sw) * 16;
  const int aoffr = (wm * 128 + ql) * GROW;
  const int boffr = 256 * GROW + (wn * 64 + ql) * GROW;
  int cs = 0, ns = 2;
#pragma unroll 1
  for (int kt = 0; kt < nk; ++kt) {
    WAIT_VM(6);
    asm volatile("s_waitcnt lgkmcnt(0)" ::: "memory");
    __builtin_amdgcn_s_barrier();
    const unsigned char* cur = smem + cs * GSTG;
    unsigned char* nd = dbase + ns * GSTG;
    const unsigned kb = (unsigned)min(kt + 2, nk - 1) * 64u;
#pragma unroll
    for (int i = 0; i < 4; ++i) GLDS16(Ab + ao[i] + kb, nd + i * 4096);
    GLDS16(bp0 + kb, nd + 16384); GLDS16(bp1 + kb, nd + 20480);
    bf16x8 af0[4], bf0[2], af1[4], bf1[2];
#pragma unroll
    for (int mi = 0; mi < 4; ++mi) af0[mi] = *(const bf16x8*)(cur + aoffr + mi * 32 * GROW + o0);
#pragma unroll
    for (int ni = 0; ni < 2; ++ni) bf0[ni] = *(const bf16x8*)(cur + boffr + ni * 32 * GROW + o0);
#pragma unroll
    for (int mi = 0; mi < 4; ++mi) af1[mi] = *(const bf16x8*)(cur + aoffr + mi * 32 * GROW + o1);
#pragma unroll
    for (int ni = 0; ni < 2; ++ni) bf1[ni] = *(const bf16x8*)(cur + boffr + ni * 32 * GROW + o1);
#pragma unroll
    for (int mi = 0; mi < 4; ++mi)
#pragma unroll
      for (int ni = 0; ni < 2; ++ni) acc[mi][ni] = MFMA32(af0[mi], bf0[ni], acc[mi][ni]);
#pragma unroll
    for (int mi = 0; mi < 4; ++mi)
#pragma unroll
      for (int ni = 0; ni < 2; ++ni) acc[mi][ni] = MFMA32(af1[mi], bf1[ni], acc[mi][ni]);
    __builtin_amdgcn_sched_group_barrier(0x100, 6, 0);
#pragma unroll
    for (int i = 0; i < 6; ++i) {
      __builtin_amdgcn_sched_group_barrier(0x008, 1, 0);
      __builtin_amdgcn_sched_group_barrier(0x100, 1, 0);
    }
    __builtin_amdgcn_sched_group_barrier(0x008, 10, 0);
    cs = (cs == 2) ? 0 : cs + 1;
    ns = (ns == 2) ? 0 : ns + 1;
  }
  WAIT_VM(0);
  __syncthreads();
  float* st = (float*)smem;
  int tl = tid;
  asm volatile("" : "+v"(tl));
#pragma unroll
  for (int q2 = 0; q2 < 2; ++q2) {
    if (wm == q2) {
#pragma unroll
      for (int mi = 0; mi < 4; ++mi)
#pragma unroll
        for (int ni = 0; ni < 2; ++ni)
#pragma unroll
          for (int r = 0; r < 16; ++r)
            st[(mi * 32 + crow(r, h)) * EST + wn * 64 + ni * 32 + ql] = acc[mi][ni][r];
    }
    __syncthreads();
    epi.process(st, 2 * q2, tl);
    epi.process(st + 64 * EST, 2 * q2 + 1, tl);
    __syncthreads();
  }
}

struct EpiStore {
  bf16_t* dst;
  int ld;
  const float* colscale;
  const float* rowscale;
  int cmode;
  DI void process(const float* st, int hm, int tid) const {
    if (cmode != 0) {
#pragma unroll
      for (int i = 0; i < 2; ++i) {
        const int c = tid + 256 * i, r = c >> 3, cc = c & 7;
        const float4 a0 = *(const float4*)(st + r * EST + cc * 8), a1 = *(const float4*)(st + r * EST + cc * 8 + 4);
        const float4 b0 = *(const float4*)(st + r * EST + 64 + cc * 8), b1 = *(const float4*)(st + r * EST + 64 + cc * 8 + 4);
        float a[8] = {a0.x, a0.y, a0.z, a0.w, a1.x, a1.y, a1.z, a1.w};
        const float b[8] = {b0.x, b0.y, b0.z, b0.w, b1.x, b1.y, b1.z, b1.w};
        if (cmode == 1) {
#pragma unroll
          for (int j = 0; j < 8; ++j) a[j] = a[j] / (1.f + __expf(-a[j])) * b[j];
        } else {
#pragma unroll
          for (int j = 0; j < 8; ++j) a[j] = a[j] * b[j];
        }
        *(uint4*)(dst + (size_t)(hm * 64 + r) * ld + cc * 8) = pack8(a);
      }
      return;
    }
#pragma unroll
    for (int i = 0; i < 4; ++i) {
      const int c = tid + 256 * i, r = c >> 4, cc = c & 15;
      const float4 a = *(const float4*)(st + r * EST + cc * 8);
      const float4 b = *(const float4*)(st + r * EST + cc * 8 + 4);
      float v[8] = {a.x, a.y, a.z, a.w, b.x, b.y, b.z, b.w};
      const int row = hm * 64 + r;
      if (rowscale) { const float rs = rowscale[row];
#pragma unroll
        for (int j = 0; j < 8; ++j) v[j] *= rs; }
      if (colscale) {
#pragma unroll
        for (int j = 0; j < 8; ++j) v[j] *= colscale[cc * 8 + j]; }
      *(uint4*)(dst + (size_t)row * ld + cc * 8) = pack8(v);
    }
  }
};

struct EpiInProj {
  unsigned char* ws;
  const float *qg, *kg;
  int row0;
  int is_ctx;
  int ct;
  DI void process(const float* st, int hm, int tid) const {
    if (ct == 5) {
      bf16_t* Vt = (bf16_t*)(ws + OFF_VT);
#pragma unroll
      for (int i = 0; i < 4; ++i) {
        const int c = tid + 256 * i, d = c >> 3, rc = c & 7;
        float v[8];
#pragma unroll
        for (int j = 0; j < 8; ++j) v[j] = st[(rc * 8 + j) * EST + d];
        const int r = row0 + hm * 64 + rc * 8;
        const int b = is_ctx ? (r >> 8) : (r >> 12);
        const int key = is_ctx ? (r & 255) : (CTXL + (r & 4095));
        *(uint4*)(Vt + ((size_t)((b * 2 + (d >> 6)) * 64 + (d & 63))) * NKEY + key) = pack8(v);
      }
      return;
    }
    const float* cos_t = (const float*)(ws + OFF_ROPE);
    const float* sin_t = cos_t + 1024;
#pragma unroll
    for (int i = 0; i < 4; ++i) {
      const int c = tid + 256 * i, r = c >> 4, cc = c & 15;
      const float4 a = *(const float4*)(st + r * EST + cc * 8);
      const float4 bb = *(const float4*)(st + r * EST + cc * 8 + 4);
      float v[8] = {a.x, a.y, a.z, a.w, bb.x, bb.y, bb.z, bb.w};
      const int grow = row0 + hm * 64 + r;
      if (ct <= 4) {
        float ss = 0.f;
#pragma unroll
        for (int j = 0; j < 8; ++j) ss += v[j] * v[j];
        ss += __shfl_xor(ss, 1); ss += __shfl_xor(ss, 2); ss += __shfl_xor(ss, 4);
        const float rinv = rsqrtf(ss * (1.f / 64.f) + LN_EPS);
        const float* g = (ct < 4 ? qg : kg) + (cc & 7) * 8;
#pragma unroll
        for (int j = 0; j < 8; ++j) v[j] = v[j] * rinv * g[j];
        if (!is_ctx) {
          const int t = grow & 4095, rowp = t >> 6, colp = t & 63;
#pragma unroll
          for (int jj = 0; jj < 4; ++jj) {
            const int pidx = (cc & 7) * 4 + jj;
            const int pos = (pidx < 16) ? rowp : colp;
            const float cs = cos_t[pos * 16 + (pidx & 15)], sn = sin_t[pos * 16 + (pidx & 15)];
            const float x0 = v[2 * jj], x1 = v[2 * jj + 1];
            v[2 * jj] = x0 * cs - x1 * sn;
            v[2 * jj + 1] = x0 * sn + x1 * cs;
          }
        }
        if (ct < 4) {
#pragma unroll
          for (int j = 0; j < 8; ++j) v[j] *= QSCALE;
          *(uint4*)((bf16_t*)(ws + OFF_Q) + (size_t)grow * 512 + ct * 128 + cc * 8) = pack8(v);
        } else {
          const int b = is_ctx ? (grow >> 8) : (grow >> 12);
          const int key = is_ctx ? (grow & 255) : (CTXL + (grow & 4095));
          *(uint4*)((bf16_t*)(ws + OFF_K) + ((size_t)(b * 2 + (cc >> 3)) * NKEY + key) * 64 + (cc & 7) * 8) = pack8(v);
        }
      } else {
        *(uint4*)((bf16_t*)(ws + OFF_P) + (size_t)grow * 512 + (ct - 6) * 128 + cc * 8) = pack8(v);
      }
    }
  }
};

DI void cvt_tile(const float* __restrict__ src, bf16_t* dst, int K, int N, int kt, int nt, float* st) {
  const int tid = threadIdx.x;
  const int k0 = kt * 64, n0 = nt * 64;
  __syncthreads();
#pragma unroll
  for (int i = 0; i < 4; ++i) {
    const int k = (tid >> 4) + 16 * i, n4 = (tid & 15) * 4;
    const f32x4 v = __builtin_nontemporal_load((const f32x4*)(src + (size_t)(k0 + k) * N + n0 + n4));
    st[k * 65 + n4 + 0] = v.x; st[k * 65 + n4 + 1] = v.y; st[k * 65 + n4 + 2] = v.z; st[k * 65 + n4 + 3] = v.w;
  }
  __syncthreads();
#pragma unroll
  for (int i = 0; i < 2; ++i) {
    const int c = tid + 256 * i, n = c >> 3, kc = c & 7;
    float v[8];
#pragma unroll
    for (int j = 0; j < 8; ++j) v[j] = st[(kc * 8 + j) * 65 + n];
    *(uint4*)(dst + (size_t)(n0 + n) * K + k0 + kc * 8) = pack8(v);
  }
}

DI void modgemv_item(const Params& p, int item, float* sm) {
  const int tid = threadIdx.x, lane = tid & 63, wave = tid >> 6;
  const int l = item / 192, n0 = (item % 192) * 32;
  float* red = sm + 5120;
  __syncthreads();
  for (int i = tid; i < 5120; i += 256) {
    const int r = i >> 10, k = i & 1023;
    const float cv = (r < 4) ? p.c[r * 1024 + k] : p.c_ctx[k];
    sm[i] = cv / (1.f + expf(-cv));
  }
  __syncthreads();
  const int sub = lane >> 3, c4 = (lane & 7) * 4;
  f32x4 a0 = {0.f, 0.f, 0.f, 0.f}, a1 = a0, a2 = a0, a3 = a0, a4 = a0;
  const float* w = p.w_mod + (size_t)l * 1024 * 6144 + n0 + c4;
  const int kb = wave * 256 + sub;
#pragma unroll 8
  for (int kk = 0; kk < 32; ++kk) {
    const int k = kb + kk * 8;
    const f32x4 wv = __builtin_nontemporal_load((const f32x4*)(w + (size_t)k * 6144));
    a0 += sm[k] * wv; a1 += sm[1024 + k] * wv; a2 += sm[2048 + k] * wv; a3 += sm[3072 + k] * wv; a4 += sm[4096 + k] * wv;
  }
#pragma unroll
  for (int j = 0; j < 4; ++j) {
#pragma unroll
    for (int o = 8; o <= 32; o <<= 1) {
      a0[j] += __shfl_xor(a0[j], o); a1[j] += __shfl_xor(a1[j], o); a2[j] += __shfl_xor(a2[j], o);
      a3[j] += __shfl_xor(a3[j], o); a4[j] += __shfl_xor(a4[j], o);
    }
  }
  if (sub == 0) {
    *(f32x4*)(red + (wave * 5 + 0) * 32 + c4) = a0; *(f32x4*)(red + (wave * 5 + 1) * 32 + c4) = a1; *(f32x4*)(red + (wave * 5 + 2) * 32 + c4) = a2;
    *(f32x4*)(red + (wave * 5 + 3) * 32 + c4) = a3; *(f32x4*)(red + (wave * 5 + 4) * 32 + c4) = a4;
  }
  __syncthreads();
  float* modv = (float*)(p.ws + OFF_MOD);
  if (tid < 160) {
    const int r = tid >> 5, ln = tid & 31;
    float s2 = p.b_mod[l * 6144 + n0 + ln];
#pragma unroll
    for (int w4 = 0; w4 < 4; ++w4) s2 += red[(w4 * 5 + r) * 32 + ln];
    modv[(size_t)(l * 5 + r) * 6144 + n0 + ln] = s2;
  }
}

DI void phase_prologue(const Params& p, unsigned char* smem) {
  constexpr int N_GEMV = 384, N_ROPE = 1;
  constexpr int T_IN = 16 * 20, T_POOL = 16, T_OUT = 256, T_CIN = 16 * 48, T_COUT = 256, T_EXP = 8192;
  constexpr int total = N_GEMV + N_ROPE + T_IN + T_POOL + T_OUT;
  float* sm = (float*)smem;
  for (int it = blockIdx.x; it < total; it += gridDim.x) {
    int t = it;
    if (t < N_GEMV) { modgemv_item(p, t, sm); continue; }
    t -= N_GEMV;
    if (t < N_ROPE) {
      float* cos_t = (float*)(p.ws + OFF_ROPE);
      for (int i = threadIdx.x; i < 1024; i += 256) {
        const int pos = i >> 4, fi = i & 15;
        const float inv = exp2f(-(float)fi * (13.287712379549449f / 16.f));
        const float ang = (float)pos * inv;
        cos_t[i] = cosf(ang); cos_t[1024 + i] = sinf(ang);
      }
      continue;
    }
    t -= N_ROPE;
    if (t < T_IN) { cvt_tile(p.w_mix_in, (bf16_t*)(p.ws + OFF_WT_IN), 1024, 1280, t / 20, t % 20, sm); continue; }
    t -= T_IN;
    if (t < T_POOL) { const int g = t >> 2, r = t & 3;
      cvt_tile(p.w_pool_grp + g * 16384, (bf16_t*)(p.ws + OFF_WT_POOL) + g * 16384, 128, 128, r >> 1, r & 1, sm); continue; }
    t -= T_POOL;
    cvt_tile(p.w_mix_out, (bf16_t*)(p.ws + OFF_WT_OUT), 1024, 1024, t >> 4, t & 15, sm);
  }
}

constexpr int N_LATE = 768 + 256 + 3 * 8192;
DI void cvt_late_tile(const Params& p, int t, float* sm) {
  if (t < 768) { cvt_tile(p.w_conv_in, (bf16_t*)(p.ws + OFF_WT_CIN), 1024, 3072, t / 48, t % 48, sm); return; }
  t -= 768;
  if (t < 256) { cvt_tile(p.w_conv_out, (bf16_t*)(p.ws + OFF_WT_COUT), 1024, 1024, t >> 4, t & 15, sm); return; }
  t -= 256;
  const int which = t >> 13, r = t & 8191, mat = r >> 8, tt = r & 255;
  const float* src = (which == 0 ? p.w_exp_gate : which == 1 ? p.w_exp_up : p.w_exp_down) + (size_t)mat * 1048576;
  bf16_t* dst = (bf16_t*)(p.ws + (which == 0 ? OFF_WT_G : which == 1 ? OFF_WT_U : OFF_WT_D)) + (size_t)mat * 1048576;
  cvt_tile(src, dst, 1024, 1024, tt >> 4, tt & 15, sm);
}
struct CvtDesc { const float* src; bf16_t* dst; int K, N, k0, n0; };
DI CvtDesc cvt_late_desc(const Params& p, int t) {
  CvtDesc d;
  if (t < 768) { d.src = p.w_conv_in; d.dst = (bf16_t*)(p.ws + OFF_WT_CIN); d.K = 1024; d.N = 3072; d.k0 = (t / 48) * 64; d.n0 = (t % 48) * 64; return d; }
  t -= 768;
  if (t < 256) { d.src = p.w_conv_out; d.dst = (bf16_t*)(p.ws + OFF_WT_COUT); d.K = 1024; d.N = 1024; d.k0 = (t >> 4) * 64; d.n0 = (t & 15) * 64; return d; }
  t -= 256;
  const int which = t >> 13, r = t & 8191, mat = r >> 8, tt = r & 255;
  d.src = (which == 0 ? p.w_exp_gate : which == 1 ? p.w_exp_up : p.w_exp_down) + (size_t)mat * 1048576;
  d.dst = (bf16_t*)(p.ws + (which == 0 ? OFF_WT_G : which == 1 ? OFF_WT_U : OFF_WT_D)) + (size_t)mat * 1048576;
  d.K = 1024; d.N = 1024; d.k0 = (tt >> 4) * 64; d.n0 = (tt & 15) * 64;
  return d;
}
DI int late_n_idle() { return 0; }
DI int late_n_early() { return min(14 * late_n_idle(), N_LATE); }
DI void cvt_late_range(const Params& p, int i0, int i1, float* sm) {
  const int base = late_n_early();
  for (int i = i0; i < i1; ++i) { const int t = base + blockIdx.x + i * gridDim.x; if (t < N_LATE) cvt_late_tile(p, t, sm); }
}

DI void phase_mod_input(const Params& p) {
  const float* modv = (const float*)(p.ws + OFF_MOD);
  bf16_t* uA = (bf16_t*)(p.ws + OFF_UA);
  bf16_t* uC = (bf16_t*)(p.ws + OFF_UCTX);
  const int total = (NTOK + NCTX) * 128;
  for (int i = blockIdx.x * 256 + threadIdx.x; i < total; i += gridDim.x * 256) {
    const int row = i >> 7, c8 = (i & 127) * 8;
    const float* src; bf16_t* dst; int mr;
    if (row < NTOK) { src = p.x + (size_t)row * D + c8; dst = uA + (size_t)row * D + c8; mr = row >> 12; }
    else { const int r = row - NTOK; src = p.ctx + (size_t)r * D + c8; dst = uC + (size_t)r * D + c8; mr = 4; }
    const float* sh = modv + (size_t)mr * 6144 + c8;
    const float* sc = sh + 1024;
    const float4 a = *(const float4*)src, b = *(const float4*)(src + 4);
    const float4 s0 = *(const float4*)sh, s1 = *(const float4*)(sh + 4);
    const float4 c0 = *(const float4*)sc, c1 = *(const float4*)(sc + 4);
    float v[8] = {a.x * (1.f + c0.x) + s0.x, a.y * (1.f + c0.y) + s0.y, a.z * (1.f + c0.z) + s0.z, a.w * (1.f + c0.w) + s0.w,
                  b.x * (1.f + c1.x) + s1.x, b.y * (1.f + c1.y) + s1.y, b.z * (1.f + c1.z) + s1.z, b.w * (1.f + c1.w) + s1.w};
    *(uint4*)dst = pack8(v);
  }
}

#define XCD_LOOP(k, n_x) const int x = blockIdx.x & 7, nper_ = gridDim.x >> 3; for (int k = blockIdx.x >> 3; k < (n_x); k += nper_)

DI void phase_inproj(const Params& p, unsigned char* smem) {
  const bf16_t* Wt = (const bf16_t*)(p.ws + OFF_WT_IN);
  const int lrow = threadIdx.x >> 2;
  XCD_LOOP(k, 81) {
    EpiInProj e; e.ws = p.ws; e.qg = p.q_norm_g; e.kg = p.k_norm_g;
    const bf16_t* A; int rt, ct;
    if (k < 80) { rt = 8 * x + k / 10; ct = k % 10; A = (const bf16_t*)(p.ws + OFF_UA); e.is_ctx = 0; }
    else { rt = x >> 1; ct = 4 + (x & 1); A = (const bf16_t*)(p.ws + OFF_UCTX); e.is_ctx = 1; }
    e.row0 = rt * 256; e.ct = ct;
    unsigned a_off[4];
#pragma unroll
    for (int i = 0; i < 4; ++i) a_off[i] = (unsigned)(rt * 256 + lrow + 64 * i) * D;
    const bf16_t* B = Wt + (size_t)ct * 128 * D;
    gemm_tile(A, a_off, B, B + (size_t)64 * D, D, D, smem, e);
  }
  {
    const int nper = gridDim.x >> 3, j = blockIdx.x >> 3, n_idle = late_n_idle();
    if (n_idle > 0 && j >= 17) {
      const int rank = (blockIdx.x & 7) * (nper - 17) + (j - 17), n_early = late_n_early();
      for (int t = rank; t < n_early; t += n_idle) cvt_late_tile(p, t, (float*)smem);
    }
  }
}

template <int HW>
DI void pooled_one(const bf16_t* __restrict__ P, bf16_t* __restrict__ PO, int row, int c8) {
  const int t = row & 4095, base = row - t;
  u32x4 v[2 * HW];
#pragma unroll
  for (int k = 0; k < 2 * HW; ++k) {
    const int sc = min(max(t - HW + k, 0), S - 1);
    v[k] = *(const u32x4*)(P + (size_t)(base + sc) * 512 + c8);
  }
  float acc[8] = {0.f, 0.f, 0.f, 0.f, 0.f, 0.f, 0.f, 0.f};
#pragma unroll
  for (int k = 0; k < 2 * HW; ++k) {
    const int sr = t - HW + k;
    const float w = (sr >= 0 && sr < S) ? 1.f : 0.f;
    acc[0] += w * bflo(v[k].x); acc[1] += w * bfhi(v[k].x); acc[2] += w * bflo(v[k].y); acc[3] += w * bfhi(v[k].y);
    acc[4] += w * bflo(v[k].z); acc[5] += w * bfhi(v[k].z); acc[6] += w * bflo(v[k].w); acc[7] += w * bfhi(v[k].w);
  }
  const float rc = 1.f / (float)(min(t + HW, S) - max(t - HW, 0));
  const u32x4 sv = v[HW];
  float o[8] = {acc[0] * rc - bflo(sv.x), acc[1] * rc - bfhi(sv.x), acc[2] * rc - bflo(sv.y), acc[3] * rc - bfhi(sv.y),
                acc[4] * rc - bflo(sv.z), acc[5] * rc - bfhi(sv.z), acc[6] * rc - bflo(sv.w), acc[7] * rc - bfhi(sv.w)};
  *(uint4*)(PO + (size_t)row * 512 + c8) = pack8(o);
}
DI void phase_pooled(const Params& p) {
  const bf16_t* P = (const bf16_t*)(p.ws + OFF_P);
  bf16_t* PO = (bf16_t*)(p.ws + OFF_POOLED);
  const int total = NTOK * 64;
  for (int i = blockIdx.x * 256 + threadIdx.x; i < total; i += gridDim.x * 256) {
    const int lane = i & 63, wq = i >> 6, g = wq & 3, row = (wq >> 2) * 4 + (lane >> 4), c8 = g * 128 + (lane & 15) * 8;
    if (g == 0) pooled_one<1>(P, PO, row, c8);
    else if (g == 1) pooled_one<2>(P, PO, row, c8);
    else if (g == 2) pooled_one<4>(P, PO, row, c8);
    else pooled_one<8>(P, PO, row, c8);
  }
}

constexpr int AK_ST = 144, AV_ST = 136;
constexpr int ABUF = 64 * AK_ST + 64 * AV_ST;

constexpr int CVT_R0 = 36864, CVT_RSZ = 16384;
DI int late_tile_of(int i) { const int t = late_n_early() + (int)blockIdx.x + i * (int)gridDim.x; return (t < N_LATE) ? t : -1; }
DI void cvt_dma_issue(const Params& p, int t, unsigned char* reg, int tid) {
  const CvtDesc d = cvt_late_desc(p, t);
  const int lane = tid & 63, wave = tid >> 6;
#pragma unroll
  for (int i = 0; i < 4; ++i) {
    const int k = (i * 4 + wave) * 4 + (lane >> 4), pos = lane & 15;
    const float* g = d.src + (size_t)(d.k0 + k) * d.N + d.n0 + ((pos ^ ((k >> 3) & 7)) << 2);
    __builtin_amdgcn_global_load_lds((const unsigned*)g, (unsigned*)(reg + (i * 4 + wave) * 1024), 16, 0, 2);
  }
}
DI void cvt_lds_store(const Params& p, int t, const unsigned char* reg, int tid) {
  const CvtDesc d = cvt_late_desc(p, t);
  const float* R = (const float*)reg;
#pragma unroll
  for (int i = 0; i < 2; ++i) {
    const int c = tid + 256 * i, n = c >> 3, kc = c & 7;
    float v[8];
#pragma unroll
    for (int jj = 0; jj < 8; ++jj) v[jj] = R[(kc * 8 + jj) * 64 + ((((n >> 2) ^ kc) & 15) << 2) + (n & 3)];
    const uint4 o4 = pack8(v);
    __builtin_nontemporal_store((u32x4){o4.x, o4.y, o4.z, o4.w}, (u32x4*)(d.dst + (size_t)(d.n0 + n) * d.K + d.k0 + kc * 8));
  }
}

DI void attn_item(const Params& p, int item, unsigned char* smem, int cvt_i0, int cvt_n) {
  int tid_ = threadIdx.x;
  asm volatile("" : "+v"(tid_));
  const int tid = tid_, lane = tid & 63, wave = tid >> 6, ql = lane & 31, h = lane >> 5;
  const int qb = item & 15, head = (item >> 4) & 7, b = item >> 7, kvh = head >> 2;
  const int tok0 = b * S + qb * 256 + wave * 64 + ql;
  bf16x8 qf[2][4];
#pragma unroll
  for (int g = 0; g < 2; ++g) {
    const bf16_t* Qp = (const bf16_t*)(p.ws + OFF_Q) + (size_t)(tok0 + g * 32) * 512 + head * 64;
#pragma unroll
    for (int s = 0; s < 4; ++s) qf[g][s] = *(const bf16x8*)(Qp + s * 16 + h * 8);
  }
  const bf16_t* Kg = (const bf16_t*)(p.ws + OFF_K) + (size_t)(b * 2 + kvh) * NKEY * 64;
  const bf16_t* Vg = (const bf16_t*)(p.ws + OFF_VT) + (size_t)(b * 2 + kvh) * 64 * NKEY;
  const int lr = tid >> 3, kc = tid & 7;
  const bf16_t* kp = Kg + (size_t)lr * 64 + kc * 8;
  const bf16_t* vp = Vg + (size_t)lr * NKEY + kc * 8;
  u32x4 rk0 = *(const u32x4*)kp, rk1 = *(const u32x4*)(kp + 32 * 64);
  u32x4 rv0 = *(const u32x4*)vp, rv1 = *(const u32x4*)(vp + (size_t)32 * NKEY);
  const int wko = lr * AK_ST + kc * 16, wvo = 64 * AK_ST + lr * AV_ST + kc * 16;
  __syncthreads();
  {
    unsigned char* wk = smem + wko; unsigned char* wv = smem + wvo;
    *(u32x4*)wk = rk0; *(u32x4*)(wk + 32 * AK_ST) = rk1;
    *(u32x2*)wv = rv0.xy; *(u32x2*)(wv + 8) = rv0.zw; *(u32x2*)(wv + 32 * AV_ST) = rv1.xy; *(u32x2*)(wv + 32 * AV_ST + 8) = rv1.zw;
  }
  __syncthreads();
  f32x16 o[2][2];
#pragma unroll
  for (int r = 0; r < 16; ++r) { o[0][0][r] = 0.f; o[0][1][r] = 0.f; o[1][0][r] = 0.f; o[1][1][r] = 0.f; }
  float m_old[2] = {-1e30f, -1e30f}, lsum[2] = {0.f, 0.f};
  constexpr int NT = NKEY / 64;
  for (int j = 0; j < NT; ++j) {
    const unsigned char* sK = smem + (j & 1) * ABUF;
    const unsigned char* sV = sK + 64 * AK_ST;
    int tid2 = tid;
    asm volatile("" : "+v"(tid2));
    if (j < cvt_n) { const int t = late_tile_of(cvt_i0 + j); if (t >= 0) cvt_dma_issue(p, t, smem + CVT_R0 + (j & 1) * CVT_RSZ, tid2); }
    if (j >= 1 && j <= cvt_n) { const int t = late_tile_of(cvt_i0 + j - 1); if (t >= 0) cvt_lds_store(p, t, smem + CVT_R0 + ((j - 1) & 1) * CVT_RSZ, tid2); }
    __builtin_amdgcn_sched_barrier(0);
    if (j + 1 < NT) {
      const int key0 = (j + 1) * 64;
      rk0 = *(const u32x4*)(kp + (size_t)key0 * 64); rk1 = *(const u32x4*)(kp + (size_t)(key0 + 32) * 64);
      rv0 = *(const u32x4*)(vp + key0); rv1 = *(const u32x4*)(vp + (size_t)32 * NKEY + key0);
    }
    f32x16 st[2][2];
#pragma unroll
    for (int g = 0; g < 2; ++g)
#pragma unroll
      for (int kt = 0; kt < 2; ++kt)
#pragma unroll
        for (int r = 0; r < 16; ++r) st[g][kt][r] = 0.f;
#pragma unroll
    for (int kt = 0; kt < 2; ++kt)
#pragma unroll
      for (int s = 0; s < 4; ++s) {
        const bf16x8 kf = *(const bf16x8*)(sK + (kt * 32 + ql) * AK_ST + s * 32 + h * 16);
        st[0][kt] = MFMA32(kf, qf[0][s], st[0][kt]);
        st[1][kt] = MFMA32(kf, qf[1][s], st[1][kt]);
      }
#pragma unroll
    for (int g = 0; g < 2; ++g) {
      float mx = st[g][0][0];
#pragma unroll
      for (int r = 0; r < 16; ++r) { mx = fmaxf(mx, st[g][0][r]); mx = fmaxf(mx, st[g][1][r]); }
      mx = fmaxf(mx, __shfl_xor(mx, 32));
      const float m_new = fmaxf(m_old[g], mx);
      if (__any(m_new > m_old[g])) {
        const float alpha = __builtin_amdgcn_exp2f(m_old[g] - m_new);
        m_old[g] = m_new;
        o[g][0] = o[g][0] * alpha; o[g][1] = o[g][1] * alpha; lsum[g] *= alpha;
      }
      st[g][0] = st[g][0] - m_old[g]; st[g][1] = st[g][1] - m_old[g];
#pragma unroll
      for (int kt = 0; kt < 2; ++kt)
#pragma unroll
        for (int r = 0; r < 16; ++r) { st[g][kt][r] = __builtin_amdgcn_exp2f(st[g][kt][r]); lsum[g] += st[g][kt][r]; }
    }
#pragma unroll
    for (int kt = 0; kt < 2; ++kt)
#pragma unroll
      for (int s2 = 0; s2 < 2; ++s2) {
        bf16x8 pf[2];
#pragma unroll
        for (int g = 0; g < 2; ++g) {
          uint4 pk = make_uint4(pack2(st[g][kt][8 * s2 + 0], st[g][kt][8 * s2 + 1]), pack2(st[g][kt][8 * s2 + 2], st[g][kt][8 * s2 + 3]),
                                pack2(st[g][kt][8 * s2 + 4], st[g][kt][8 * s2 + 5]), pack2(st[g][kt][8 * s2 + 6], st[g][kt][8 * s2 + 7]));
          pf[g] = __builtin_bit_cast(bf16x8, pk);
        }
#pragma unroll
        for (int dt = 0; dt < 2; ++dt) {
          const unsigned char* va = sV + (dt * 32 + ql) * AV_ST + (kt * 32 + 16 * s2 + 4 * h) * 2;
          const uint2 lo = *(const uint2*)va, hi = *(const uint2*)(va + 16);
          const uint4 vv = make_uint4(lo.x, lo.y, hi.x, hi.y);
          const bf16x8 vf = __builtin_bit_cast(bf16x8, vv);
          o[0][dt] = MFMA32(vf, pf[0], o[0][dt]);
          o[1][dt] = MFMA32(vf, pf[1], o[1][dt]);
        }
      }
    if (j + 1 < NT) {
      unsigned char* wk = smem + ((j + 1) & 1) * ABUF + wko; unsigned char* wv = smem + ((j + 1) & 1) * ABUF + wvo;
      *(u32x4*)wk = rk0; *(u32x4*)(wk + 32 * AK_ST) = rk1;
      *(u32x2*)wv = rv0.xy; *(u32x2*)(wv + 8) = rv0.zw; *(u32x2*)(wv + 32 * AV_ST) = rv1.xy; *(u32x2*)(wv + 32 * AV_ST + 8) = rv1.zw;
    }
    asm volatile("s_waitcnt vmcnt(0)" ::: "memory");
    __syncthreads();
  }
  int tokl = b * S + qb * 256 + wave * 64 + ql;
  asm volatile("" : "+v"(tokl));
#pragma unroll
  for (int g = 0; g < 2; ++g) {
    const float lt = lsum[g] + __shfl_xor(lsum[g], 32);
    const float il = 1.f / lt;
    bf16_t* Op = (bf16_t*)(p.ws + OFF_CAT) + (size_t)(tokl + g * 32) * 1024 + head * 64;
#pragma unroll
    for (int dt = 0; dt < 2; ++dt)
#pragma unroll
      for (int q4 = 0; q4 < 4; ++q4) {
        const uint2 w2 = make_uint2(pack2(o[g][dt][4 * q4] * il, o[g][dt][4 * q4 + 1] * il), pack2(o[g][dt][4 * q4 + 2] * il, o[g][dt][4 * q4 + 3] * il));
        *(uint2*)(Op + dt * 32 + 8 * q4 + 4 * h) = w2;
      }
  }
}

DI void phase_attn_pool(const Params& p, unsigned char* smem) {
  constexpr int N_ATT = NB_ * 8 * 16, N_POOL = 64 * 4;
  const int x = blockIdx.x & 7, j = blockIdx.x >> 3, nper = gridDim.x >> 3;
  const int n_i = (N_LATE - late_n_early() + gridDim.x - 1) / gridDim.x;
  float* sm = (float*)smem;
  int done = 0;
  for (int k = j; k < N_ATT / 8; k += nper) {
    const int take = min(n_i - done, 67);
    attn_item(p, (x >> 1) * 128 + ((x & 1) * 4 + (k >> 4)) * 16 + (k & 15), smem, done, take);
    done += take;
  }
  cvt_late_range(p, done, n_i, sm);
  int tidl = threadIdx.x;
  asm volatile("" : "+v"(tidl));
  const int lrow = tidl >> 2;
  for (int k = j; k < N_POOL / 8; k += nper) {
    const int t = k * 8 + x, rt = t >> 2, g = t & 3;
    {
      const bf16_t* P = (const bf16_t*)(p.ws + OFF_P);
      bf16_t* PO = (bf16_t*)(p.ws + OFF_POOLED);
#pragma unroll 1
      for (int i = 0; i < 16; ++i) {
        const int idx = tidl + 256 * i, row = rt * 256 + (idx >> 4), c8 = g * 128 + (idx & 15) * 8;
        if (g == 0) pooled_one<1>(P, PO, row, c8);
        else if (g == 1) pooled_one<2>(P, PO, row, c8);
        else if (g == 2) pooled_one<4>(P, PO, row, c8);
        else pooled_one<8>(P, PO, row, c8);
      }
      asm volatile("s_waitcnt vmcnt(0)" ::: "memory");
      __syncthreads();
    }
    unsigned a_off[4];
#pragma unroll
    for (int i = 0; i < 4; ++i) a_off[i] = (unsigned)(rt * 256 + lrow + 64 * i) * 512 + g * 128;
    const bf16_t* B = (const bf16_t*)(p.ws + OFF_WT_POOL) + g * 16384;
    EpiStore e; e.dst = (bf16_t*)(p.ws + OFF_CAT) + (size_t)rt * 256 * 1024 + 512 + g * 128; e.ld = 1024;
    e.colscale = p.pool_scale + g * 128; e.rowscale = nullptr; e.cmode = 0;
    gemm_tile((const bf16_t*)(p.ws + OFF_POOLED), a_off, B, B + 64 * 128, 128, 128, smem, e);
  }
}

DI void phase_gemm_plain(const bf16_t* A, const bf16_t* Wt, bf16_t* dst, int ncol_tiles, int ldd, unsigned char* smem) {
  const int lrow = threadIdx.x >> 2;
  XCD_LOOP(k, 8 * ncol_tiles) {
    const int rt = 8 * x + k / ncol_tiles, ct = k % ncol_tiles;
    unsigned a_off[4];
#pragma unroll
    for (int i = 0; i < 4; ++i) a_off[i] = (unsigned)(rt * 256 + lrow + 64 * i) * D;
    const bf16_t* B = Wt + (size_t)ct * 128 * D;
    EpiStore e; e.dst = dst + (size_t)rt * 256 * ldd + ct * 128; e.ld = ldd; e.colscale = nullptr; e.rowscale = nullptr; e.cmode = 0;
    gemm_tile(A, a_off, B, B + (size_t)64 * D, D, D, smem, e);
  }
}

DI void phase_ln_mix(const Params& p, int l, unsigned char* smem) {
  const int tid = threadIdx.x, lane = tid & 63, wave = tid >> 6;
  float* wrT = (float*)smem;
  __syncthreads();
  {
    const float* wr = p.w_router + (size_t)l * D * NE;
    for (int i = tid; i < D * NE / 4; i += 256) {
      const float4 v = *(const float4*)(wr + i * 4);
      const int c = i >> 2, e0 = (i & 3) * 4;
      wrT[(e0 + 0) * 1024 + c] = v.x; wrT[(e0 + 1) * 1024 + c] = v.y; wrT[(e0 + 2) * 1024 + c] = v.z; wrT[(e0 + 3) * 1024 + c] = v.w;
    }
  }
  __syncthreads();
  const float* hin = (l == 0) ? p.x : p.out;
  float* hout = (float*)(p.ws + OFF_H1);
  const bf16_t* Y = (const bf16_t*)(p.ws + OFF_Y);
  bf16_t* U = (bf16_t*)(p.ws + OFF_UA);
  float* aff = (float*)(p.ws + OFF_AFF);
  const float* modv = (const float*)(p.ws + OFF_MOD);
  const float* lg = p.ln_mix_g + l * D;
  const float* lb = p.ln_mix_b + l * D;
  const int r0 = (int)(((long long)blockIdx.x * NTOK) / gridDim.x), r1 = (int)(((long long)(blockIdx.x + 1) * NTOK) / gridDim.x);
  const int stride = 4;
  int row = r0 + wave;
  f32x4 LG[4], LB[4], GT[4], SH[4], SC[4];
#pragma unroll
  for (int i = 0; i < 4; ++i) { LG[i] = *(const f32x4*)(lg + lane * 4 + 256 * i); LB[i] = *(const f32x4*)(lb + lane * 4 + 256 * i); }
  int cur_b = -1;
  float4 hv0, hv1, hv2, hv3; u32x2 yv0, yv1, yv2, yv3;
  if (row < r1) {
    const float* hp = hin + (size_t)row * D + lane * 4; const bf16_t* yp = Y + (size_t)row * D + lane * 4;
    { const f32x4 t0_ = __builtin_nontemporal_load((const f32x4*)hp), t1_ = __builtin_nontemporal_load((const f32x4*)(hp + 256)), t2_ = __builtin_nontemporal_load((const f32x4*)(hp + 512)), t3_ = __builtin_nontemporal_load((const f32x4*)(hp + 768));
      hv0 = make_float4(t0_.x, t0_.y, t0_.z, t0_.w); hv1 = make_float4(t1_.x, t1_.y, t1_.z, t1_.w); hv2 = make_float4(t2_.x, t2_.y, t2_.z, t2_.w); hv3 = make_float4(t3_.x, t3_.y, t3_.z, t3_.w); }
    yv0 = *(const u32x2*)yp; yv1 = *(const u32x2*)(yp + 256); yv2 = *(const u32x2*)(yp + 512); yv3 = *(const u32x2*)(yp + 768);
  }
  for (; row < r1; row += stride) {
    const int b = row >> 12, t = row & 4095;
    if (b != cur_b) {
      const float* mb = modv + (size_t)(l * 5 + b) * 6144 + lane * 4;
#pragma unroll
      for (int i = 0; i < 4; ++i) { GT[i] = *(const f32x4*)(mb + 2 * 1024 + 256 * i); SH[i] = *(const f32x4*)(mb + 3 * 1024 + 256 * i); SC[i] = *(const f32x4*)(mb + 4 * 1024 + 256 * i); }
      cur_b = b;
    }
    const float4 ch[4] = {hv0, hv1, hv2, hv3};
    const u32x2 cy[4] = {yv0, yv1, yv2, yv3};
    {
      const int nrow = row + stride;
      if (nrow < r1) {
        const float* hp = hin + (size_t)nrow * D + lane * 4; const bf16_t* yp = Y + (size_t)nrow * D + lane * 4;
        { const f32x4 t0_ = __builtin_nontemporal_load((const f32x4*)hp), t1_ = __builtin_nontemporal_load((const f32x4*)(hp + 256)), t2_ = __builtin_nontemporal_load((const f32x4*)(hp + 512)), t3_ = __builtin_nontemporal_load((const f32x4*)(hp + 768));
      hv0 = make_float4(t0_.x, t0_.y, t0_.z, t0_.w); hv1 = make_float4(t1_.x, t1_.y, t1_.z, t1_.w); hv2 = make_float4(t2_.x, t2_.y, t2_.z, t2_.w); hv3 = make_float4(t3_.x, t3_.y, t3_.z, t3_.w); }
        yv0 = *(const u32x2*)yp; yv1 = *(const u32x2*)(yp + 256); yv2 = *(const u32x2*)(yp + 512); yv3 = *(const u32x2*)(yp + 768);
      }
    }
    float v[16];
    float sum = 0.f;
#pragma unroll
    for (int i = 0; i < 4; ++i) {
      const int c = lane * 4 + 256 * i;
      const f32x4 gt = GT[i];
      v[4 * i + 0] = ALPHA * ch[i].x + gt.x * bflo(cy[i].x); v[4 * i + 1] = ALPHA * ch[i].y + gt.y * bfhi(cy[i].x);
      v[4 * i + 2] = ALPHA * ch[i].z + gt.z * bflo(cy[i].y); v[4 * i + 3] = ALPHA * ch[i].w + gt.w * bfhi(cy[i].y);
      sum += v[4 * i] + v[4 * i + 1] + v[4 * i + 2] + v[4 * i + 3];
    }
    const float mean = wave_sum(sum) * (1.f / 1024.f);
    float sq = 0.f;
#pragma unroll
    for (int j = 0; j < 16; ++j) { v[j] -= mean; sq += v[j] * v[j]; }
    const float rstd = rsqrtf(wave_sum(sq) * (1.f / 1024.f) + LN_EPS);
#pragma unroll
    for (int i = 0; i < 4; ++i) {
      const int c = lane * 4 + 256 * i;
      const f32x4 g4 = LG[i], b4 = LB[i];
      float4 hn;
      hn.x = v[4 * i] * rstd * g4.x + b4.x; hn.y = v[4 * i + 1] * rstd * g4.y + b4.y;
      hn.z = v[4 * i + 2] * rstd * g4.z + b4.z; hn.w = v[4 * i + 3] * rstd * g4.w + b4.w;
      __builtin_nontemporal_store((f32x4){hn.x, hn.y, hn.z, hn.w}, (f32x4*)(hout + (size_t)row * D + c));
      const f32x4 sh = SH[i], sc4 = SC[i];
      v[4 * i] = hn.x * (1.f + sc4.x) + sh.x; v[4 * i + 1] = hn.y * (1.f + sc4.y) + sh.y;
      v[4 * i + 2] = hn.z * (1.f + sc4.z) + sh.z; v[4 * i + 3] = hn.w * (1.f + sc4.w) + sh.w;
      *(uint2*)(U + (size_t)row * D + c) = make_uint2(pack2(v[4 * i], v[4 * i + 1]), pack2(v[4 * i + 2], v[4 * i + 3]));
    }
    float a[16];
#pragma unroll
    for (int e = 0; e < 16; ++e) {
      float acc = 0.f;
#pragma unroll
      for (int i = 0; i < 4; ++i) {
        const float4 w4 = *(const float4*)(wrT + e * 1024 + lane * 4 + 256 * i);
        acc += v[4 * i] * w4.x + v[4 * i + 1] * w4.y + v[4 * i + 2] * w4.z + v[4 * i + 3] * w4.w;
      }
      a[e] = acc;
      if ((e & 3) == 3) asm volatile("" ::: "memory");
    }
    const bool b5 = (lane & 32) != 0, b4_ = (lane & 16) != 0, b3 = (lane & 8) != 0, b2 = (lane & 4) != 0;
    float r8[8], r4[4], r2[2];
#pragma unroll
    for (int i = 0; i < 8; ++i) { const float snd = b5 ? a[i] : a[i + 8]; const float kp = b5 ? a[i + 8] : a[i]; r8[i] = kp + __shfl_xor(snd, 32); }
#pragma unroll
    for (int i = 0; i < 4; ++i) { const float snd = b4_ ? r8[i] : r8[i + 4]; const float kp = b4_ ? r8[i + 4] : r8[i]; r4[i] = kp + __shfl_xor(snd, 16); }
#pragma unroll
    for (int i = 0; i < 2; ++i) { const float snd = b3 ? r4[i] : r4[i + 2]; const float kp = b3 ? r4[i + 2] : r4[i]; r2[i] = kp + __shfl_xor(snd, 8); }
    float lgt;
    { const float snd = b2 ? r2[0] : r2[1]; const float kp = b2 ? r2[1] : r2[0]; lgt = kp + __shfl_xor(snd, 4); }
    lgt += __shfl_xor(lgt, 2); lgt += __shfl_xor(lgt, 1);
    float mx = lgt;
    mx = fmaxf(mx, __shfl_xor(mx, 4)); mx = fmaxf(mx, __shfl_xor(mx, 8)); mx = fmaxf(mx, __shfl_xor(mx, 16)); mx = fmaxf(mx, __shfl_xor(mx, 32));
    const float ex = expf(lgt - mx);
    float se = ex;
    se += __shfl_xor(se, 4); se += __shfl_xor(se, 8); se += __shfl_xor(se, 16); se += __shfl_xor(se, 32);
    if ((lane & 3) == 0) aff[(size_t)(b * 16 + ((lane >> 2) & 15)) * S + t] = ex / se;
  }
}

DI void phase_topk(const Params& p, unsigned char* smem) {
  const int tid = threadIdx.x, lane = tid & 63, wave = tid >> 6;
  unsigned* hist = (unsigned*)smem;
  unsigned* wtot = hist + 256;
  const float* aff = (const float*)(p.ws + OFF_AFF);
  int* idx = (int*)(p.ws + OFF_IDX);
  float* gatev = (float*)(p.ws + OFF_GATEV);
  int* inv = (int*)(p.ws + OFF_INV);
  for (int be = blockIdx.x; be < NB_ * NE; be += gridDim.x) {
    const int b = be >> 4, e = be & 15;
    unsigned v[16];
#pragma unroll
    for (int i = 0; i < 4; ++i) {
      const float4 f = *(const float4*)(aff + (size_t)be * S + tid * 16 + i * 4);
      v[4 * i] = __float_as_uint(f.x); v[4 * i + 1] = __float_as_uint(f.y); v[4 * i + 2] = __float_as_uint(f.z); v[4 * i + 3] = __float_as_uint(f.w);
    }
    unsigned prefix = 0, mask = 0; int need = CAP;
#pragma unroll 1
    for (int pass = 0; pass < 4; ++pass) {
      const int shift = 24 - 8 * pass;
      __syncthreads();
      hist[tid] = 0;
      __syncthreads();
#pragma unroll
      for (int j = 0; j < 16; ++j) if ((v[j] & mask) == prefix) atomicAdd(&hist[(v[j] >> shift) & 255], 1u);
      __syncthreads();
      {
        const int hcount = (int)hist[tid];
        int sfx = hcount;
#pragma unroll
        for (int o = 1; o < 64; o <<= 1) { const int n = __shfl_down(sfx, o); if (lane + o < 64) sfx += n; }
        if (lane == 0) wtot[wave] = (unsigned)sfx;
        __syncthreads();
        for (int w = wave + 1; w < 4; ++w) sfx += (int)wtot[w];
        if (sfx >= need && sfx - hcount < need) { wtot[4] = (unsigned)tid; wtot[5] = (unsigned)(sfx - hcount); }
        __syncthreads();
        const int bin = (int)wtot[4];
        need -= (int)wtot[5];
        prefix |= (unsigned)bin << shift; mask |= 255u << shift;
      }
    }
    const unsigned T = prefix;
    int cg_ = 0, ce_ = 0;
#pragma unroll
    for (int j = 0; j < 16; ++j) { cg_ += (v[j] > T); ce_ += (v[j] == T); }
    int packed = cg_ | (ce_ << 16);
    int incl = packed;
#pragma unroll
    for (int o = 1; o < 64; o <<= 1) { const int n = __shfl_up(incl, o); if (lane >= o) incl += n; }
    __syncthreads();
    if (lane == 63) wtot[wave] = (unsigned)incl;
    __syncthreads();
    int base = incl - packed;
    for (int w = 0; w < wave; ++w) base += (int)wtot[w];
    int bg = base & 0xffff, beq = base >> 16;
    const int ngt = CAP - need;
#pragma unroll
    for (int j = 0; j < 16; ++j) {
      const int t = tid * 16 + j;
      int slot = -1;
      if (v[j] > T) { slot = bg; ++bg; }
      else if (v[j] == T) { if (beq < need) slot = ngt + beq; ++beq; }
      if (slot >= 0) { idx[be * CAP + slot] = t; gatev[be * CAP + slot] = __uint_as_float(v[j]); }
      inv[(size_t)(b * S + t) * NE + e] = slot;
    }
  }
}

DI void phase_moe_up(const Params& p, int l, unsigned char* smem) {
  const int lrow = threadIdx.x >> 2;
  const int* idx = (const int*)(p.ws + OFF_IDX);
  const bf16_t* U = (const bf16_t*)(p.ws + OFF_UA);
  bf16_t* act = (bf16_t*)(p.ws + OFF_ACT);
  XCD_LOOP(k, 256) {
    const int e = 4 * (k >> 6) + (x >> 1), m = k & 7, ct = (x & 1) * 8 + ((k >> 3) & 7);
    const int b = m >> 1, rt = m & 1, be = b * 16 + e;
    unsigned a_off[4];
#pragma unroll
    for (int i = 0; i < 4; ++i) a_off[i] = (unsigned)(b * S + idx[be * CAP + rt * 256 + lrow + 64 * i]) * D;
    const size_t wo = ((size_t)(l * 16 + e) * 1024 + ct * 64) * 1024;
    EpiStore ep; ep.dst = act + ((size_t)be * CAP + rt * 256) * FF + ct * 64; ep.ld = FF; ep.colscale = nullptr; ep.rowscale = nullptr; ep.cmode = 1;
    gemm_tile(U, a_off, (const bf16_t*)(p.ws + OFF_WT_G) + wo, (const bf16_t*)(p.ws + OFF_WT_U) + wo, D, D, smem, ep);
  }
}
DI void phase_moe_down(const Params& p, int l, unsigned char* smem) {
  const int lrow = threadIdx.x >> 2;
  const bf16_t* act = (const bf16_t*)(p.ws + OFF_ACT);
  bf16_t* Y2 = (bf16_t*)(p.ws + OFF_Y2);
  const float* gatev = (const float*)(p.ws + OFF_GATEV);
  XCD_LOOP(k, 128) {
    const int e = 8 * (k >> 6) + x, m = k & 7, ct = (k >> 3) & 7;
    const int b = m >> 1, rt = m & 1, be = b * 16 + e;
    unsigned a_off[4];
#pragma unroll
    for (int i = 0; i < 4; ++i) a_off[i] = (unsigned)(be * CAP + rt * 256 + lrow + 64 * i) * FF;
    const bf16_t* B = (const bf16_t*)(p.ws + OFF_WT_D) + ((size_t)(l * 16 + e) * 1024 + ct * 128) * 1024;
    EpiStore ep; ep.dst = Y2 + ((size_t)be * CAP + rt * 256) * D + ct * 128; ep.ld = D; ep.colscale = nullptr;
    ep.rowscale = gatev + be * CAP + rt * 256; ep.cmode = 0;
    gemm_tile(act, a_off, B, B + (size_t)64 * FF, FF, FF, smem, ep);
  }
}

DI void phase_ln_ffn(const Params& p, int l) {
  const int tid = threadIdx.x, lane = tid & 63, wave = tid >> 6;
  const float* hin = (const float*)(p.ws + OFF_H1);
  float* hout = p.out;
  const bf16_t* Y2 = (const bf16_t*)(p.ws + OFF_Y2);
  const int* inv = (const int*)(p.ws + OFF_INV);
  bf16_t* U = (bf16_t*)(p.ws + OFF_UB);
  const float* modv = (const float*)(p.ws + OFF_MOD);
  const float* lg = p.ln_ffn_g + l * D;
  const float* lb = p.ln_ffn_b + l * D;
  const int r0 = (int)(((long long)blockIdx.x * NTOK) / gridDim.x), r1 = (int)(((long long)(blockIdx.x + 1) * NTOK) / gridDim.x);
  const int stride = 4;
  int row = r0 + wave;
  f32x4 LG[4], LB[4], GT[4], SH[4], SC[4];
#pragma unroll
  for (int i = 0; i < 4; ++i) { LG[i] = *(const f32x4*)(lg + lane * 4 + 256 * i); LB[i] = *(const f32x4*)(lb + lane * 4 + 256 * i); SH[i] = LG[i]; SC[i] = LG[i]; }
  int cur_b = -1;
  float4 hv0, hv1, hv2, hv3; int nslot = -1;
  if (row < r1) {
    const float* hp = hin + (size_t)row * D + lane * 4;
    { const f32x4 t0_ = __builtin_nontemporal_load((const f32x4*)hp), t1_ = __builtin_nontemporal_load((const f32x4*)(hp + 256)), t2_ = __builtin_nontemporal_load((const f32x4*)(hp + 512)), t3_ = __builtin_nontemporal_load((const f32x4*)(hp + 768));
      hv0 = make_float4(t0_.x, t0_.y, t0_.z, t0_.w); hv1 = make_float4(t1_.x, t1_.y, t1_.z, t1_.w); hv2 = make_float4(t2_.x, t2_.y, t2_.z, t2_.w); hv3 = make_float4(t3_.x, t3_.y, t3_.z, t3_.w); }
    nslot = (lane < 16) ? inv[(size_t)row * NE + lane] : -1;
  }
  for (; row < r1; row += stride) {
    const int b = row >> 12;
    if (b != cur_b) {
      const float* mb = modv + (size_t)(l * 5 + b) * 6144 + lane * 4;
      const float* mn = modv + (size_t)(5 + b) * 6144 + lane * 4;
#pragma unroll
      for (int i = 0; i < 4; ++i) {
        GT[i] = *(const f32x4*)(mb + 5 * 1024 + 256 * i);
        if (l == 0) { SH[i] = *(const f32x4*)(mn + 256 * i); SC[i] = *(const f32x4*)(mn + 1024 + 256 * i); }
      }
      cur_b = b;
    }
    const float4 ch[4] = {hv0, hv1, hv2, hv3};
    const int myslot = nslot;
    {
      const int nrow = row + stride;
      if (nrow < r1) {
        const float* hp = hin + (size_t)nrow * D + lane * 4;
        { const f32x4 t0_ = __builtin_nontemporal_load((const f32x4*)hp), t1_ = __builtin_nontemporal_load((const f32x4*)(hp + 256)), t2_ = __builtin_nontemporal_load((const f32x4*)(hp + 512)), t3_ = __builtin_nontemporal_load((const f32x4*)(hp + 768));
      hv0 = make_float4(t0_.x, t0_.y, t0_.z, t0_.w); hv1 = make_float4(t1_.x, t1_.y, t1_.z, t1_.w); hv2 = make_float4(t2_.x, t2_.y, t2_.z, t2_.w); hv3 = make_float4(t3_.x, t3_.y, t3_.z, t3_.w); }
        nslot = (lane < 16) ? inv[(size_t)nrow * NE + lane] : -1;
      }
    }
    float f[16];
#pragma unroll
    for (int j = 0; j < 16; ++j) f[j] = 0.f;
    unsigned m = (unsigned)__ballot(myslot >= 0);
    const bf16_t* ybase = Y2 + (size_t)b * 16 * CAP * D + lane * 4;
    while (m) {
      int e0 = __ffs(m) - 1; m &= m - 1;
      int e1 = -1, e2 = -1, e3 = -1;
      if (m) { e1 = __ffs(m) - 1; m &= m - 1; }
      if (m) { e2 = __ffs(m) - 1; m &= m - 1; }
      if (m) { e3 = __ffs(m) - 1; m &= m - 1; }
      const int s0 = __shfl(myslot, e0), s1 = __shfl(myslot, e1 < 0 ? 0 : e1), s2 = __shfl(myslot, e2 < 0 ? 0 : e2), s3 = __shfl(myslot, e3 < 0 ? 0 : e3);
      u32x2 y0[4], y1[4], y2[4], y3[4];
#pragma unroll
      for (int i = 0; i < 4; ++i) { y1[i] = (u32x2){0u, 0u}; y2[i] = (u32x2){0u, 0u}; y3[i] = (u32x2){0u, 0u}; }
      {
        const bf16_t* yr = ybase + ((size_t)e0 * CAP + s0) * D;
#pragma unroll
        for (int i = 0; i < 4; ++i) y0[i] = *(const u32x2*)(yr + 256 * i);
      }
      if (e1 >= 0) { const bf16_t* yr = ybase + ((size_t)e1 * CAP + s1) * D;
#pragma unroll
        for (int i = 0; i < 4; ++i) y1[i] = *(const u32x2*)(yr + 256 * i); }
      if (e2 >= 0) { const bf16_t* yr = ybase + ((size_t)e2 * CAP + s2) * D;
#pragma unroll
        for (int i = 0; i < 4; ++i) y2[i] = *(const u32x2*)(yr + 256 * i); }
      if (e3 >= 0) { const bf16_t* yr = ybase + ((size_t)e3 * CAP + s3) * D;
#pragma unroll
        for (int i = 0; i < 4; ++i) y3[i] = *(const u32x2*)(yr + 256 * i); }
#pragma unroll
      for (int i = 0; i < 4; ++i) {
        f[4 * i] += (bflo(y0[i].x) + bflo(y1[i].x)) + (bflo(y2[i].x) + bflo(y3[i].x));
        f[4 * i + 1] += (bfhi(y0[i].x) + bfhi(y1[i].x)) + (bfhi(y2[i].x) + bfhi(y3[i].x));
        f[4 * i + 2] += (bflo(y0[i].y) + bflo(y1[i].y)) + (bflo(y2[i].y) + bflo(y3[i].y));
        f[4 * i + 3] += (bfhi(y0[i].y) + bfhi(y1[i].y)) + (bfhi(y2[i].y) + bfhi(y3[i].y));
      }
    }
    float v[16];
    float sum = 0.f;
#pragma unroll
    for (int i = 0; i < 4; ++i) {
      const int c = lane * 4 + 256 * i;
      const f32x4 gt = GT[i];
      v[4 * i + 0] = ALPHA * ch[i].x + gt.x * f[4 * i]; v[4 * i + 1] = ALPHA * ch[i].y + gt.y * f[4 * i + 1];
      v[4 * i + 2] = ALPHA * ch[i].z + gt.z * f[4 * i + 2]; v[4 * i + 3] = ALPHA * ch[i].w + gt.w * f[4 * i + 3];
      sum += v[4 * i] + v[4 * i + 1] + v[4 * i + 2] + v[4 * i + 3];
    }
    const float mean = wave_sum(sum) * (1.f / 1024.f);
    float sq = 0.f;
#pragma unroll
    for (int j = 0; j < 16; ++j) { v[j] -= mean; sq += v[j] * v[j]; }
    const float rstd = rsqrtf(wave_sum(sq) * (1.f / 1024.f) + LN_EPS);
#pragma unroll
    for (int i = 0; i < 4; ++i) {
      const int c = lane * 4 + 256 * i;
      const f32x4 g4 = LG[i], b4 = LB[i];
      float4 hn;
      hn.x = v[4 * i] * rstd * g4.x + b4.x; hn.y = v[4 * i + 1] * rstd * g4.y + b4.y;
      hn.z = v[4 * i + 2] * rstd * g4.z + b4.z; hn.w = v[4 * i + 3] * rstd * g4.w + b4.w;
      __builtin_nontemporal_store((f32x4){hn.x, hn.y, hn.z, hn.w}, (f32x4*)(hout + (size_t)row * D + c));
      if (l == 0) {
        const f32x4 sh = SH[i], sc4 = SC[i];
        *(uint2*)(U + (size_t)row * D + c) = make_uint2(pack2(hn.x * (1.f + sc4.x) + sh.x, hn.y * (1.f + sc4.y) + sh.y),
                                                        pack2(hn.z * (1.f + sc4.z) + sh.z, hn.w * (1.f + sc4.w) + sh.w));
      }
    }
  }
}

DI void phase_conv_in(const Params& p, unsigned char* smem) {
  const int lrow = threadIdx.x >> 2;
  const bf16_t* U = (const bf16_t*)(p.ws + OFF_UB);
  const bf16_t* Wt = (const bf16_t*)(p.ws + OFF_WT_CIN);
  XCD_LOOP(k, 192) {
    const int rt = 8 * x + k / 24, cc = k % 24;
    unsigned a_off[4];
#pragma unroll
    for (int i = 0; i < 4; ++i) a_off[i] = (unsigned)(rt * 256 + lrow + 64 * i) * D;
    EpiStore ep; ep.ld = D; ep.colscale = nullptr; ep.rowscale = nullptr;
    if (cc < 16) {
      ep.dst = (bf16_t*)(p.ws + OFF_CX) + (size_t)rt * 256 * D + cc * 64; ep.cmode = 2;
      gemm_tile(U, a_off, Wt + (size_t)(1024 + cc * 64) * D, Wt + (size_t)(2048 + cc * 64) * D, D, D, smem, ep);
    } else {
      const int ct = cc - 16;
      ep.dst = (bf16_t*)(p.ws + OFF_BG) + (size_t)rt * 256 * D + ct * 128; ep.cmode = 0;
      const bf16_t* B = Wt + (size_t)(ct * 128) * D;
      gemm_tile(U, a_off, B, B + (size_t)64 * D, D, D, smem, ep);
    }
  }
}
DI void phase_conv_gate(const Params& p) {
  const bf16_t* BG = (const bf16_t*)(p.ws + OFF_BG);
  const bf16_t* CX = (const bf16_t*)(p.ws + OFF_CX);
  bf16_t* Z = (bf16_t*)(p.ws + OFF_Z);
  const int total = NTOK * 128;
  for (int i = blockIdx.x * 256 + threadIdx.x; i < total; i += gridDim.x * 256) {
    const int row = i >> 7, c8 = (i & 127) * 8, t = row & 4095;
    float xm[8], x0[8], xp[8], bg[8], z[8];
    unpack8(*(const uint4*)(CX + (size_t)row * D + c8), x0);
    if (t > 0) unpack8(*(const uint4*)(CX + (size_t)(row - 1) * D + c8), xm);
    else {
#pragma unroll
      for (int j = 0; j < 8; ++j) xm[j] = 0.f; }
    if (t < S - 1) unpack8(*(const uint4*)(CX + (size_t)(row + 1) * D + c8), xp);
    else {
#pragma unroll
      for (int j = 0; j < 8; ++j) xp[j] = 0.f; }
    unpack8(*(const uint4*)(BG + (size_t)row * D + c8), bg);
#pragma unroll
    for (int j = 0; j < 8; ++j)
      z[j] = bg[j] * (p.conv_w[c8 + j] * xm[j] + p.conv_w[1024 + c8 + j] * x0[j] + p.conv_w[2048 + c8 + j] * xp[j]);
    *(uint4*)(Z + (size_t)row * D + c8) = pack8(z);
  }
}

#define XB_TMO      128
#define XB_XCNT(j)  (256  + 64 * (j))
#define XB_XSUB(j)  (1280 + 64 * (j))
#define XB_XGEN(j)  (2304 + 64 * (j))
#define XB_TOP      3328
#define XB_TOPGEN   3392
#define XCD_BAR_WORDS 3456
#define XB_SPIN_CAP (1u << 20)
DI unsigned xb_ld(unsigned* p) { return __hip_atomic_load(p, __ATOMIC_RELAXED, __HIP_MEMORY_SCOPE_AGENT); }
DI unsigned xb_add(unsigned* p, unsigned v) { return __hip_atomic_fetch_add(p, v, __ATOMIC_RELAXED, __HIP_MEMORY_SCOPE_AGENT); }
DI unsigned xb_xcc_id() { return (unsigned)__builtin_amdgcn_s_getreg((3 << 11) | 20) & 0xFu; }
#define XB_SPIN(cond, bar) do { unsigned _sp = 0; while (cond) { __builtin_amdgcn_s_sleep(1); \
    if ((++_sp & 255u) == 0u) { if (xb_ld(&(bar)[XB_TMO])) break; if (_sp > XB_SPIN_CAP) { atomicAdd(&(bar)[XB_TMO], 1u); break; } } } } while (0)
struct XcdBarrier { unsigned* bar; unsigned x; volatile unsigned* st; };
DI XcdBarrier xcd_barrier_post(unsigned* bar, volatile unsigned* st) {
  XcdBarrier b; b.bar = bar; b.x = xb_xcc_id(); b.st = st;
  if (threadIdx.x == 0) (void)xb_add(&bar[XB_XCNT(b.x)], 1u);
  return b;
}
DI void xcd_barrier_complete(unsigned* bar, unsigned x, unsigned& nloc, unsigned& nx) {
  const unsigned G = gridDim.x;
  unsigned sum, cnt, mine, sp = 0u;
  for (;;) {
    sum = 0u; cnt = 0u; mine = 0u;
#pragma unroll
    for (unsigned j = 0; j < 16; ++j) { const unsigned c = xb_ld(&bar[XB_XCNT(j)]); sum += c; cnt += (c > 0u) ? 1u : 0u; mine = (j == x) ? c : mine; }
    if (sum == G) break;
    __builtin_amdgcn_s_sleep(1);
    if ((++sp & 255u) == 0u) { if (xb_ld(&bar[XB_TMO])) break; if (sp > XB_SPIN_CAP) { atomicAdd(&bar[XB_TMO], 1u); break; } }
  }
  nloc = mine > 0u ? mine : 1u; nx = cnt > 0u ? cnt : 1u;
}
DI void xcd_barrier(const XcdBarrier& b) {
  asm volatile("s_waitcnt vmcnt(0)" ::: "memory");
  __syncthreads();
  if (threadIdx.x == 0) {
    unsigned* bar = b.bar;
    __builtin_amdgcn_s_waitcnt(0);
    unsigned nloc = b.st[0], nx = b.st[1];
    if (nloc == 0u) { xcd_barrier_complete(bar, b.x, nloc, nx); b.st[0] = nloc; b.st[1] = nx; }
    const unsigned old = xb_add(&bar[XB_XSUB(b.x)], 1u);
    const unsigned gen = old / nloc;
    if (old + 1u == (gen + 1u) * nloc) {
      __builtin_amdgcn_fence(__ATOMIC_RELEASE, "agent");
      asm volatile("s_waitcnt vmcnt(0)" ::: "memory");
      const unsigned og = xb_add(&bar[XB_TOP], 1u);
      const unsigned tg = og / nx;
      if (og + 1u == (tg + 1u) * nx) xb_add(&bar[XB_TOPGEN], 1u);
      else XB_SPIN(xb_ld(&bar[XB_TOPGEN]) == tg, bar);
      __builtin_amdgcn_fence(__ATOMIC_ACQUIRE, "agent");
      xb_add(&bar[XB_XGEN(b.x)], 1u);
      asm volatile("s_waitcnt vmcnt(0)" ::: "memory");
    } else {
      XB_SPIN(xb_ld(&bar[XB_XGEN(b.x)]) == gen, bar);
      __builtin_amdgcn_fence(__ATOMIC_ACQUIRE, "agent");
      asm volatile("s_waitcnt vmcnt(0)" ::: "memory");
    }
  }
  __syncthreads();
}

__global__ void __launch_bounds__(256, 2) fwd_megakernel(Params p) {
  extern __shared__ __attribute__((aligned(16))) unsigned char smem[];
  cg::grid_group grid = cg::this_grid();
  if (p.ph_lo < 0) grid.sync();
  volatile unsigned* xst = (volatile unsigned*)(smem + LDS_BYTES - 16);
  if (threadIdx.x == 0) { xst[0] = 0u; xst[1] = 0u; }
  __syncthreads();
  XcdBarrier xb = xcd_barrier_post((unsigned*)(p.ws + OFF_BAR), xst);
#ifndef DUPMASK
#define DUPMASK 0u
#endif
#define PH(n, call) if (p.ph_lo <= (n) && (n) < p.ph_hi) { call; if ((DUPMASK >> (n)) & 1u) { xcd_barrier(xb); call; } if ((n) + 1 < p.ph_hi) xcd_barrier(xb); }
  PH(0, phase_prologue(p, smem))
  PH(1, phase_mod_input(p))
  PH(2, phase_inproj(p, smem))
  PH(4, phase_attn_pool(p, smem))
  PH(5, phase_gemm_plain((const bf16_t*)(p.ws + OFF_CAT), (const bf16_t*)(p.ws + OFF_WT_OUT), (bf16_t*)(p.ws + OFF_Y), 8, D, smem))
  PH(6, phase_ln_mix(p, 0, smem))
  PH(7, phase_topk(p, smem))
  PH(8, phase_moe_up(p, 0, smem))
  PH(9, phase_moe_down(p, 0, smem))
  PH(10, phase_ln_ffn(p, 0))
  PH(11, phase_conv_in(p, smem))
  PH(12, phase_conv_gate(p))
  PH(13, phase_gemm_plain((const bf16_t*)(p.ws + OFF_Z), (const bf16_t*)(p.ws + OFF_WT_COUT), (bf16_t*)(p.ws + OFF_Y), 8, D, smem))
  PH(14, phase_ln_mix(p, 1, smem))
  PH(15, phase_topk(p, smem))
  PH(16, phase_moe_up(p, 1, smem))
  PH(17, phase_moe_down(p, 1, smem))
  PH(18, phase_ln_ffn(p, 1))
#undef PH
}

extern "C" void kernel_launch(void* const* d_in, const int* in_sizes, int n_in, void* d_out, int out_size, void* d_ws,
                              size_t ws_size, hipStream_t stream) {
  static int grid_blocks = 0;
  if (!grid_blocks) {
    if (n_in != 23 || ws_size < WS_END) { fprintf(stderr, "kernel_launch: unexpected n_in %d or ws_size %zu (need %zu)\n", n_in, ws_size, (size_t)WS_END); grid_blocks = -1; return; }
    int dev = 0, cus = 0, per_cu = 0;
    hipGetDevice(&dev);
    hipDeviceGetAttribute(&cus, hipDeviceAttributeMultiprocessorCount, dev);
    if (hipFuncSetAttribute((const void*)fwd_megakernel, hipFuncAttributeMaxDynamicSharedMemorySize, LDS_BYTES) != hipSuccess) { fprintf(stderr, "kernel_launch: hipFuncSetAttribute(%d B dynamic LDS) failed\n", LDS_BYTES); grid_blocks = -1; return; }
    hipOccupancyMaxActiveBlocksPerMultiprocessor(&per_cu, fwd_megakernel, 256, LDS_BYTES);
    if (per_cu < 1) per_cu = 1;
    if (per_cu > 2) per_cu = 2;
    grid_blocks = cus * per_cu;
  }
  if (grid_blocks < 0) return;
  Params p{};
  const float** f = (const float**)&p;
  for (int i = 0; i < 23; ++i) f[i] = (const float*)d_in[i];
  p.out = (float*)d_out; p.ws = (unsigned char*)d_ws; p.ph_lo = 0; p.ph_hi = 19;
  (void)hipMemsetAsync((unsigned char*)d_ws + OFF_BAR, 0, 16384, stream);
  void* args[] = {&p};
  hipError_t e = hipLaunchCooperativeKernel((void*)fwd_megakernel, dim3(grid_blocks), dim3(256), args, LDS_BYTES, stream);
  if (e != hipSuccess) fprintf(stderr, "cooperative launch failed: %s (grid %d)\n", hipGetErrorString(e), grid_blocks);
}
```
